# Optimizing an MI355X kernel written in HIP

```python
import math
import jax
import jax.numpy as jnp
from jax import lax
import numpy as np

D_MODEL = 1024
BATCH = 16
SEQ = 4096
DEPTH = 2

N_MIXERS = 2
N_GLA_LAYERS = (DEPTH + 1) // 2
N_HGRN_LAYERS = DEPTH // 2
CHUNK = 64
NORM_EPS = 1e-6

GLA_HEADS = 4
GLA_KEY = D_MODEL // 2
GLA_VAL = D_MODEL
GLA_DK = GLA_KEY // GLA_HEADS
GLA_DV = GLA_VAL // GLA_HEADS
GLA_GATE_RANK = 16
GLA_GATE_NORMALIZER = 16.0
GLA_IN = 2 * GLA_KEY + 2 * GLA_VAL + GLA_GATE_RANK

HG_EXPAND = 128
HG_HEADS = D_MODEL // HG_EXPAND
HG_DK = HG_EXPAND
HG_DV = D_MODEL // HG_HEADS
HG_KEY = HG_HEADS * HG_DK
HG_VAL = HG_HEADS * HG_DV
HG_IN = 2 * HG_KEY + 2 * HG_VAL

D_FF = int(math.ceil(8 * D_MODEL / 3 / 256)) * 256

kernel_name = "gla_hgrn2_interleaved_hybrid"


def rms_norm(x, gain):
    xf = x.astype(jnp.float32)
    inv = lax.rsqrt(jnp.mean(xf * xf, axis=-1, keepdims=True) + NORM_EPS)
    return (xf * inv).astype(x.dtype) * gain


def chunked_gated_linear_attention(q, k, v, g_log):
    out_dtype = v.dtype
    B, S, H, DK = q.shape
    DV = v.shape[-1]
    N = S // CHUNK

    def to_chunks(t):
        return t.astype(jnp.float32).reshape(B, N, CHUNK, H, t.shape[-1]).transpose(1, 0, 3, 2, 4)

    qc, kc, vc, gc = to_chunks(q), to_chunks(k), to_chunks(v), to_chunks(g_log)
    causal = jnp.tril(jnp.ones((CHUNK, CHUNK), dtype=bool))[:, :, None]

    def step(state, inp):
        q_c, k_c, v_c, g_c = inp
        b = jnp.cumsum(g_c, axis=2)
        o_inter = jnp.einsum('bhcd,bhde->bhce', q_c * jnp.exp(b), state)
        diff = b[:, :, :, None, :] - b[:, :, None, :, :]
        decay = jnp.exp(jnp.where(causal, diff, -jnp.inf))
        scores = jnp.einsum('bhid,bhjd,bhijd->bhij', q_c, k_c, decay)
        o = o_inter + jnp.einsum('bhij,bhje->bhie', scores, v_c)
        b_last = b[:, :, -1:, :]
        k_dec = k_c * jnp.exp(b_last - b)
        state = jnp.exp(b_last[:, :, 0, :])[..., None] * state + jnp.einsum('bhcd,bhce->bhde', k_dec, v_c)
        return state, o

    state0 = jnp.zeros((B, H, DK, DV), jnp.float32)
    _, o = lax.scan(step, state0, (qc, kc, vc, gc))
    return o.transpose(1, 0, 3, 2, 4).reshape(B, S, H, DV).astype(out_dtype)


def gla_mixer(h, w_in, w_gate_up, b_gate, head_norm, w_out):
    B, S, _ = h.shape
    proj = h @ w_in
    q, k, v, r, gd = jnp.split(
        proj, [GLA_KEY, 2 * GLA_KEY, 2 * GLA_KEY + GLA_VAL, 2 * GLA_KEY + 2 * GLA_VAL], axis=-1)
    g_log = jax.nn.log_sigmoid((gd @ w_gate_up + b_gate).astype(jnp.float32)) / GLA_GATE_NORMALIZER
    q = q.reshape(B, S, GLA_HEADS, GLA_DK) * (GLA_DK ** -0.5)
    k = k.reshape(B, S, GLA_HEADS, GLA_DK)
    v = v.reshape(B, S, GLA_HEADS, GLA_DV)
    g_log = g_log.reshape(B, S, GLA_HEADS, GLA_DK)
    o = chunked_gated_linear_attention(q, k, v, g_log)
    o = rms_norm(o, head_norm) * jax.nn.silu(r.reshape(B, S, GLA_HEADS, GLA_DV))
    return o.reshape(B, S, GLA_VAL) @ w_out


def hgrn2_mixer(h, w_in, lb, out_norm, w_out):
    B, S, _ = h.shape
    proj = h @ w_in
    q, f, i, g = jnp.split(proj, [HG_KEY, 2 * HG_KEY, 2 * HG_KEY + HG_VAL], axis=-1)
    q = jax.nn.silu(q)
    f = f.astype(jnp.float32)
    log_forget = jnp.logaddexp(jnp.log(lb), jnp.log1p(-lb) + jax.nn.log_sigmoid(f))
    k = (1.0 - lb) * jax.nn.sigmoid(-f)
    q = q.reshape(B, S, HG_HEADS, HG_DK) * (HG_DK ** -0.5)
    k = k.reshape(B, S, HG_HEADS, HG_DK)
    log_forget = log_forget.reshape(B, S, HG_HEADS, HG_DK)
    v = i.reshape(B, S, HG_HEADS, HG_DV)
    o = chunked_gated_linear_attention(q, k, v, log_forget).reshape(B, S, HG_VAL)
    o = rms_norm(o, out_norm) * jax.nn.silu(g)
    return o @ w_out


def swiglu_ffn(h, w_in, w_out):
    gate, up = jnp.split(h @ w_in, [D_FF], axis=-1)
    return (jax.nn.silu(gate) * up) @ w_out


def setup_inputs(seed: int = 0) -> dict:
    key = jax.random.key(seed)
    ks = jax.random.split(key, 20)
    f32 = jnp.float32

    def w(k, shape, fan_in):
        return jax.random.normal(k, shape, f32) * (fan_in ** -0.5)

    def gain(k, shape):
        return 1.0 + 0.02 * jax.random.normal(k, shape, f32)

    return {
        "x": jax.random.normal(ks[0], (BATCH, SEQ, D_MODEL), f32),
        "mixer_norm": gain(ks[1], (DEPTH, D_MODEL)),
        "ffn_norm": gain(ks[2], (DEPTH, D_MODEL)),
        "gla_w_in": w(ks[3], (N_GLA_LAYERS, D_MODEL, GLA_IN), D_MODEL),
        "gla_w_gate_up": w(ks[4], (N_GLA_LAYERS, GLA_GATE_RANK, GLA_KEY), GLA_GATE_RANK),
        "gla_b_gate": 0.1 * jax.random.normal(ks[5], (N_GLA_LAYERS, GLA_KEY), f32),
        "gla_head_norm": gain(ks[6], (N_GLA_LAYERS, GLA_DV)),
        "gla_w_out": w(ks[7], (N_GLA_LAYERS, GLA_VAL, D_MODEL), GLA_VAL),
        "hgrn_w_in": w(ks[8], (N_HGRN_LAYERS, D_MODEL, HG_IN), D_MODEL),
        "hgrn_lower_bounds": 0.5 * jax.random.normal(ks[9], (DEPTH, HG_KEY), f32),
        "hgrn_out_norm": gain(ks[10], (N_HGRN_LAYERS, HG_VAL)),
        "hgrn_w_out": w(ks[11], (N_HGRN_LAYERS, HG_VAL, D_MODEL), HG_VAL),
        "ffn_w_in": w(ks[12], (DEPTH, D_MODEL, 2 * D_FF), D_MODEL),
        "ffn_w_out": w(ks[13], (DEPTH, D_FF, D_MODEL), D_FF),
        "final_norm": gain(ks[14], (D_MODEL,)),
    }


def reference(x, mixer_norm, ffn_norm, gla_w_in, gla_w_gate_up, gla_b_gate, gla_head_norm,
              gla_w_out, hgrn_w_in, hgrn_lower_bounds, hgrn_out_norm, hgrn_w_out,
              ffn_w_in, ffn_w_out, final_norm):
    lb_soft = jax.nn.softmax(hgrn_lower_bounds.astype(jnp.float32), axis=0)
    lb_table = jnp.cumsum(lb_soft, axis=0) - lb_soft[0]

    for layer in range(DEPTH):
        h = rms_norm(x, mixer_norm[layer])
        j = layer // N_MIXERS
        if layer % N_MIXERS == 0:
            mixed = gla_mixer(h, gla_w_in[j], gla_w_gate_up[j], gla_b_gate[j],
                              gla_head_norm[j], gla_w_out[j])
        else:
            mixed = hgrn2_mixer(h, hgrn_w_in[j], lb_table[layer], hgrn_out_norm[j], hgrn_w_out[j])
        x = x + mixed
        x = x + swiglu_ffn(rms_norm(x, ffn_norm[layer]), ffn_w_in[layer], ffn_w_out[layer])
    return rms_norm(x, final_norm)
```

```cpp
#include <hip/hip_runtime.h>
#include <cstdio>
#include <cstdint>
#ifndef PG8_SP2
#define PG8_SP2 true
#endif
#ifndef PG8_ALIGN
#define PG8_ALIGN true
#endif
#ifndef PG8_WGM
#define PG8_WGM 8
#endif
#define MK_PER_PHASE 0
namespace pg8 {
#define PG8_LAS __attribute__((address_space(3)))
typedef unsigned short bf16_t;
typedef short bf16x8 __attribute__((ext_vector_type(8)));
typedef float f32x4 __attribute__((ext_vector_type(4)));
typedef unsigned u32x4 __attribute__((ext_vector_type(4)));
constexpr int BM = 256, BK = 64, HALF = 128, HTB = HALF * BK * 2  , STAGE_BYTES = 8 * HTB, NXCD = 8, WGM = PG8_WGM;

__host__ __device__ __forceinline__ int lds_byte(int r, int c) { const int st = (r >> 4) * 2 + (c >> 5), rr = r & 15, cc = c & 31, ob = rr * 64 + cc * 2; return st * 1024 + (ob ^ (((ob >> 9) & 1) << 5)); }
__host__ __device__ __forceinline__ void stage_rc(int b, int& R, int& C) { const int st = b / 1024, sb = b % 1024, swz = sb ^ (((sb >> 9) & 1) << 5); R = (st >> 1) * 16 + swz / 64; C = (st & 1) * 32 + (swz % 64) / 2; }
__host__ __device__ __forceinline__ int perm32(int rho) { const int n = rho >> 4, i = rho & 15; return 8 * (i >> 2) + 4 * n + (i & 3); }

struct Unit { int pm, pn; };
struct Gemm { const bf16_t* A; const bf16_t* Bt; int M, N, K; };

struct StaticOrder {
    int nM, nN, nwg, G, c;
    __host__ __device__ void init(int M, int N, int G_, int c_) { nM = M / BM; nN = N / BM; nwg = nM * nN; G = G_; c = c_; }
    __host__ __device__ bool next(int i, Unit& u) const {
        const long L = (long)i * G + c; if (L >= nwg) return false;
        int wgid = (int)L; { const int q = nwg / NXCD, r = nwg % NXCD, xcd = wgid % NXCD, off = wgid / NXCD; wgid = (xcd < r ? xcd * (q + 1) : r * (q + 1) + (xcd - r) * q) + off; }
        const int nig = WGM * nN, gid = wgid / nig, fm = gid * WGM, gsz = (nM - fm) < WGM ? (nM - fm) : WGM;
        u.pm = fm + ((wgid % nig) % gsz); u.pn = (wgid % nig) / gsz; return true;
    }
    __device__ __forceinline__ void a_ready(const Unit&) const {}
    __device__ __forceinline__ void done(const Unit&) const {}
};
__device__ __forceinline__ unsigned cvt_pk_bf16(float lo, float hi) { unsigned r; asm volatile("v_cvt_pk_bf16_f32 %0, %1, %2" : "=v"(r) : "v"(lo), "v"(hi)); return r; }
typedef float f32x2 __attribute__((ext_vector_type(2)));
template <class Epi, class Sched, bool ALIGN_EPI = false, bool SP2 = false>
__device__ __forceinline__ void gemm_phase(PG8_LAS unsigned char* lds, const Gemm g, const Sched& S, const Epi& E) {
    const int tid = threadIdx.x, wid = __builtin_amdgcn_readfirstlane(tid >> 6), lane = tid & 63, wr = wid >> 2, wc = wid & 3, fr = lane & 15, fq = lane >> 4;
    const int K = g.K, nt = K / BK;
    unsigned voffA[2], voffB[2];
#pragma unroll
    for (int i = 0; i < 2; ++i) { int R, C; stage_rc(tid * 16 + i * 8192, R, C); const int Rb = Epi::PERM ? ((R & ~31) + perm32(R & 31)) : R;
        voffA[i] = (unsigned)(R * K + C) * 2u; voffB[i] = (unsigned)(Rb * K + C) * 2u; }
    const size_t kstep = (size_t)(BK * 2);
    const size_t hstep = (size_t)HALF * K * 2;
    const size_t tstep = 2 * hstep;
    const unsigned ldsw = (unsigned)wid * 1024u;
    const int aoff = lds_byte(wr * 64 + fr, fq * 8), boff = lds_byte(wc * 32 + fr, fq * 8);
#define PG8_SA(b, h) (((b) * 2 + (h)) * HTB)
#define PG8_SB(b, h) ((4 + (b) * 2 + (h)) * HTB)
#define PG8_STAGE(bufoff, gbase, voff) do { _Pragma("unroll") for (int _i = 0; _i < 2; ++_i) \
        __builtin_amdgcn_global_load_lds((const unsigned*)((const char*)(gbase) + (voff)[_i]), (PG8_LAS unsigned*)(lds + (bufoff) + ldsw + _i * 8192), 16, 0, 0); } while (0)
#define PG8_LDA(dst, b, h) do { _Pragma("unroll") for (int m = 0; m < 4; ++m) _Pragma("unroll") for (int k = 0; k < 2; ++k) dst[m][k] = *(const PG8_LAS bf16x8*)(lds + PG8_SA(b, h) + aoff + m * 2048 + k * 1024); } while (0)
#define PG8_LDB(dst, b, h) do { _Pragma("unroll") for (int n = 0; n < 2; ++n) _Pragma("unroll") for (int k = 0; k < 2; ++k) dst[n][k] = *(const PG8_LAS bf16x8*)(lds + PG8_SB(b, h) + boff + n * 2048 + k * 1024); } while (0)
#define PG8_MMA(ai, bj, At, Bt) do { __builtin_amdgcn_s_setprio(1); _Pragma("unroll") for (int m = 0; m < 4; ++m) _Pragma("unroll") for (int n = 0; n < 2; ++n) _Pragma("unroll") for (int k = 0; k < 2; ++k) \
        acc[ai][bj][m][n] = __builtin_amdgcn_mfma_f32_16x16x32_bf16(Bt[n][k], At[m][k], acc[ai][bj][m][n], 0, 0, 0); __builtin_amdgcn_s_setprio(0); } while (0)
#define PG8_WAIT_V(n) asm volatile("s_waitcnt vmcnt(" #n ")" ::: "memory")
#define PG8_WAIT_L(n) asm volatile("s_waitcnt lgkmcnt(" #n ")" ::: "memory")
#define PG8_BAR __builtin_amdgcn_s_barrier()
#define PG8_SCHED __builtin_amdgcn_sched_barrier(0)
    Unit cur, nxt; int ui = 0;
    if (!S.next(0, cur)) return;
    f32x4 acc[2][2][4][2];
#pragma unroll
    for (int a = 0; a < 2; ++a)
#pragma unroll
        for (int b = 0; b < 2; ++b)
#pragma unroll
            for (int m = 0; m < 4; ++m)
#pragma unroll
                for (int n = 0; n < 2; ++n) acc[a][b][m][n] = (f32x4){0.f, 0.f, 0.f, 0.f};
    bf16x8 At[4][2], B0[2][2], B1[2][2];
    const char* cA = (const char*)g.A + (size_t)cur.pm * tstep; const char* cB = (const char*)g.Bt + (size_t)cur.pn * tstep;
    S.a_ready(cur);
    if constexpr (SP2) {
        PG8_STAGE(PG8_SB(0, 0), cB, voffB); PG8_STAGE(PG8_SB(0, 1), cB + hstep, voffB); PG8_STAGE(PG8_SA(0, 0), cA, voffA); PG8_STAGE(PG8_SA(0, 1), cA + hstep, voffA);
        if (wr == 1) PG8_BAR;
        PG8_WAIT_V(2); PG8_BAR;
        PG8_STAGE(PG8_SB(1, 0), cB + kstep, voffB); PG8_STAGE(PG8_SA(1, 0), cA + kstep, voffA); PG8_STAGE(PG8_SB(1, 1), cB + hstep + kstep, voffB);
        PG8_WAIT_V(6); PG8_BAR;
    } else {
        PG8_STAGE(PG8_SB(0, 0), cB, voffB); PG8_STAGE(PG8_SA(0, 0), cA, voffA); PG8_STAGE(PG8_SB(0, 1), cB + hstep, voffB); PG8_STAGE(PG8_SA(0, 1), cA + hstep, voffA);
        if (wr == 1) PG8_BAR;
        PG8_WAIT_V(4); PG8_BAR;
        PG8_STAGE(PG8_SB(1, 0), cB + kstep, voffB); PG8_STAGE(PG8_SA(1, 0), cA + kstep, voffA); PG8_STAGE(PG8_SB(1, 1), cB + hstep + kstep, voffB);
        PG8_WAIT_V(6); PG8_BAR;
    }
    for (;;) {
        const bool has_next = S.next(ui + 1, nxt);
        const char* nA = has_next ? (const char*)g.A + (size_t)nxt.pm * tstep : cA; const char* nB = has_next ? (const char*)g.Bt + (size_t)nxt.pn * tstep : cB;
        for (int t = 0; t < nt; t += 2) {
            const bool last = (t == nt - 2);
            const char* a1 = cA + (size_t)(t + 1) * kstep;
            const char* a2 = last ? nA : cA + (size_t)(t + 2) * kstep; const char* b2 = last ? nB : cB + (size_t)(t + 2) * kstep;
            const char* a3 = a2 + kstep; const char* b3 = b2 + kstep;
            if (last && has_next) S.a_ready(nxt);
            if constexpr (SP2) {
            PG8_LDB(B0, 0, 0); PG8_LDB(B1, 0, 1); PG8_SCHED; PG8_LDA(At, 0, 0); PG8_STAGE(PG8_SA(1, 1), a1 + hstep, voffA);
            PG8_WAIT_V(8); PG8_WAIT_L(0); PG8_BAR; PG8_MMA(0, 0, At, B0); PG8_MMA(0, 1, At, B1); PG8_BAR; PG8_SCHED;
            PG8_LDA(At, 0, 1); PG8_STAGE(PG8_SB(0, 0), b2, voffB); PG8_STAGE(PG8_SB(0, 1), b2 + hstep, voffB); PG8_STAGE(PG8_SA(0, 0), a2, voffA);
            PG8_WAIT_V(8); PG8_WAIT_L(0); PG8_BAR; PG8_MMA(1, 0, At, B0); PG8_MMA(1, 1, At, B1); PG8_BAR; PG8_SCHED;
            PG8_LDB(B0, 1, 0); PG8_LDB(B1, 1, 1); PG8_SCHED; PG8_LDA(At, 1, 0); PG8_STAGE(PG8_SA(0, 1), a2 + hstep, voffA);
            PG8_WAIT_V(8); PG8_WAIT_L(0); PG8_BAR; PG8_MMA(0, 0, At, B0); PG8_MMA(0, 1, At, B1); PG8_BAR; PG8_SCHED;
            PG8_LDA(At, 1, 1); PG8_STAGE(PG8_SB(1, 0), b3, voffB); PG8_STAGE(PG8_SB(1, 1), b3 + hstep, voffB); PG8_STAGE(PG8_SA(1, 0), a3, voffA);
            PG8_WAIT_V(8); PG8_WAIT_L(0); PG8_BAR; PG8_MMA(1, 0, At, B0); PG8_MMA(1, 1, At, B1); PG8_BAR; PG8_SCHED;
            } else {
            PG8_LDB(B0, 0, 0); PG8_SCHED; PG8_LDA(At, 0, 0); PG8_STAGE(PG8_SA(1, 1), a1 + hstep, voffA);
            PG8_WAIT_L(8); PG8_BAR; PG8_WAIT_L(0); PG8_MMA(0, 0, At, B0); PG8_BAR; PG8_SCHED;
            PG8_LDB(B1, 0, 1); PG8_STAGE(PG8_SB(0, 0), b2, voffB);
            PG8_BAR; PG8_WAIT_L(0); PG8_MMA(0, 1, At, B1); PG8_BAR;
            PG8_LDA(At, 0, 1); PG8_STAGE(PG8_SA(0, 0), a2, voffA);
            PG8_BAR; PG8_WAIT_L(0); PG8_MMA(1, 0, At, B0); PG8_BAR; PG8_SCHED;
            PG8_STAGE(PG8_SB(0, 1), b2 + hstep, voffB);
            PG8_WAIT_V(6); PG8_BAR; PG8_MMA(1, 1, At, B1); PG8_BAR;
            PG8_LDB(B0, 1, 0); PG8_SCHED; PG8_LDA(At, 1, 0); PG8_STAGE(PG8_SA(0, 1), a2 + hstep, voffA);
            PG8_WAIT_L(8); PG8_BAR; PG8_WAIT_L(0); PG8_MMA(0, 0, At, B0); PG8_BAR; PG8_SCHED;
            PG8_LDB(B1, 1, 1); PG8_STAGE(PG8_SB(1, 0), b3, voffB);
            PG8_BAR; PG8_WAIT_L(0); PG8_MMA(0, 1, At, B1); PG8_BAR;
            PG8_LDA(At, 1, 1); PG8_STAGE(PG8_SA(1, 0), a3, voffA);
            PG8_BAR; PG8_WAIT_L(0); PG8_MMA(1, 0, At, B0); PG8_BAR; PG8_SCHED;
            PG8_STAGE(PG8_SB(1, 1), b3 + hstep, voffB);
            PG8_WAIT_V(6); PG8_BAR; PG8_MMA(1, 1, At, B1); PG8_BAR;
            }
        }
        if constexpr (ALIGN_EPI) { if (wr == 0) PG8_BAR; }
        if constexpr (!Epi::AFTER_DRAIN) { E(acc, cur, wr, wc, fr, fq); S.done(cur); }
        if (!has_next) break;
#pragma unroll
        for (int a = 0; a < 2; ++a)
#pragma unroll
            for (int b = 0; b < 2; ++b)
#pragma unroll
                for (int m = 0; m < 4; ++m)
#pragma unroll
                    for (int n = 0; n < 2; ++n) acc[a][b][m][n] = (f32x4){0.f, 0.f, 0.f, 0.f};
        cur = nxt; cA = nA; cB = nB; ++ui;
        if constexpr (ALIGN_EPI) { if (wr == 1) PG8_BAR; }
    }
    PG8_WAIT_V(0);
    if constexpr (!ALIGN_EPI) { if (wr == 0) PG8_BAR; }
    PG8_BAR;
    if constexpr (Epi::AFTER_DRAIN) { E.fused(acc, cur, wr, wc, fr, fq, lds, wid, lane); S.done(cur); }
#undef PG8_SA
#undef PG8_SB
#undef PG8_STAGE
#undef PG8_LDA
#undef PG8_LDB
#undef PG8_MMA
#undef PG8_WAIT_V
#undef PG8_WAIT_L
#undef PG8_BAR
#undef PG8_SCHED
}
}

namespace pg8 {
typedef unsigned u32x2 __attribute__((ext_vector_type(2)));
constexpr float NORM_EPS = 1e-6f;
__device__ __forceinline__ float fast_sigmoid(float x) { return __builtin_amdgcn_rcpf(1.0f + __builtin_amdgcn_exp2f(-1.44269504089f * x)); }
__device__ __forceinline__ float silu_f(float x) { return x * fast_sigmoid(x); }
template <int NP> __device__ __forceinline__ float row_rs(const float* parts, int row, int fq) {
    f32x4 v = (f32x4){0.f, 0.f, 0.f, 0.f};
    if (4 * fq < NP) v = *(const f32x4*)(parts + (size_t)row * NP + 4 * fq);
    float s = (v[0] + v[1]) + (v[2] + v[3]); s += __shfl_xor(s, 16); s += __shfl_xor(s, 32);
    return __builtin_amdgcn_rsqf(s * (1.0f / 1024.0f) + NORM_EPS);
}
__device__ __forceinline__ float bperm(int addr, float v) { return __builtin_bit_cast(float, __builtin_amdgcn_ds_bpermute(addr, __builtin_bit_cast(int, v))); }
template <int NP> __device__ __forceinline__ float row_rs_a(const float* parts, int row, int fq, int a16, int a32) {
    f32x4 v = (f32x4){0.f, 0.f, 0.f, 0.f};
    if (4 * fq < NP) v = *(const f32x4*)(parts + (size_t)row * NP + 4 * fq);
    float s = (v[0] + v[1]) + (v[2] + v[3]); s += bperm(a16, s); s += bperm(a32, s);
    return __builtin_amdgcn_rsqf(s * (1.0f / 1024.0f) + NORM_EPS);
}
typedef __bf16 bf16v2_t __attribute__((ext_vector_type(2)));
__device__ __forceinline__ unsigned pk_native(float a, float b) { bf16v2_t v = {(__bf16)a, (__bf16)b}; return __builtin_bit_cast(unsigned, v); }
__device__ __forceinline__ u32x4 pack8(const f32x4& a, const f32x4& b) { u32x4 w; w.x = pk_native(a[0], a[1]); w.y = pk_native(a[2], a[3]); w.z = pk_native(b[0], b[1]); w.w = pk_native(b[2], b[3]); return w; }

__device__ __forceinline__ float log2_decay_gla(float z) { return (fminf(z, 0.f) * 1.44269504089f - __builtin_amdgcn_logf(1.0f + __builtin_amdgcn_exp2f(-1.44269504089f * fabsf(z)))) * (1.0f / 16.0f); }
struct EpiProjGLA {
    static constexpr bool PERM = true, AFTER_DRAIN = false;
    bf16_t *Q, *K, *V, *R, *Z; const float* rowss; const float* bgate;
    __device__ __forceinline__ void operator()(const f32x4 (&acc)[2][2][4][2], const Unit& u, int wr, int wc, int fr, int fq) const {
        const int row0 = u.pm * BM + wr * 64 + fr;
        float rs[2][4];
#pragma unroll
        for (int ai = 0; ai < 2; ++ai)
#pragma unroll
            for (int m = 0; m < 4; ++m) rs[ai][m] = row_rs<16>(rowss, row0 + ai * HALF + m * 16, fq);
        const int pn = u.pn; bf16_t* dst; int ldc, colt, mode;
        if (pn < 2) { dst = Q; ldc = 512; colt = pn * 256; mode = 0; } else if (pn < 4) { dst = K; ldc = 512; colt = (pn - 2) * 256; mode = 1; }
        else if (pn < 8) { dst = V; ldc = 1024; colt = (pn - 4) * 256; mode = 1; } else if (pn < 12) { dst = R; ldc = 1024; colt = (pn - 8) * 256; mode = 2; }
        else { dst = Z; ldc = 512; colt = (pn - 12) * 256; mode = 3; }
        const int col0 = colt + wc * 32 + 8 * fq;
        f32x4 bv[2][2];
#pragma unroll
        for (int bj = 0; bj < 2; ++bj)
#pragma unroll
            for (int n = 0; n < 2; ++n) bv[bj][n] = (mode == 3) ? *(const f32x4*)(bgate + col0 + bj * HALF + 4 * n) : (f32x4){0.f, 0.f, 0.f, 0.f};
        const float qs = (mode == 0) ? 0.08838834764831845f : 1.0f;
#pragma unroll
        for (int ai = 0; ai < 2; ++ai)
#pragma unroll
            for (int m = 0; m < 4; ++m) { bf16_t* rowp = dst + (size_t)(row0 + ai * HALF + m * 16) * ldc + col0; const float s = rs[ai][m] * qs;
#pragma unroll
                for (int bj = 0; bj < 2; ++bj) { f32x4 v0 = acc[ai][bj][m][0] * s + bv[bj][0], v1 = acc[ai][bj][m][1] * s + bv[bj][1];
                    if (mode == 2) {
#pragma unroll
                        for (int j = 0; j < 4; ++j) { v0[j] = silu_f(v0[j]); v1[j] = silu_f(v1[j]); } }
                    if (mode == 3) {
#pragma unroll
                        for (int j = 0; j < 4; ++j) { v0[j] = log2_decay_gla(v0[j]); v1[j] = log2_decay_gla(v1[j]); } }
                    *(u32x4*)(rowp + bj * HALF) = pack8(v0, v1); } }
    }
};
struct EpiProjHG {
    static constexpr bool PERM = true, AFTER_DRAIN = false;
    bf16_t *Q, *F, *V, *G; const float* rowss; const float* lbt;
    __device__ __forceinline__ void operator()(const f32x4 (&acc)[2][2][4][2], const Unit& u, int wr, int wc, int fr, int fq) const {
        const int row0 = u.pm * BM + wr * 64 + fr;
        float rs[2][4];
#pragma unroll
        for (int ai = 0; ai < 2; ++ai)
#pragma unroll
            for (int m = 0; m < 4; ++m) rs[ai][m] = row_rs<16>(rowss, row0 + ai * HALF + m * 16, fq);
        const int pn = u.pn, t = pn >> 2; bf16_t* dst = (t == 0) ? Q : (t == 1) ? F : (t == 2) ? V : G;
        const bool act = (t == 0) || (t == 3); const float qs = (t == 0) ? 0.08838834764831845f : 1.0f;
        const int col0 = (pn & 3) * 256 + wc * 32 + 8 * fq;
        f32x4 lb[2][2];
#pragma unroll
        for (int bj = 0; bj < 2; ++bj)
#pragma unroll
            for (int n = 0; n < 2; ++n) lb[bj][n] = (t == 1) ? *(const f32x4*)(lbt + col0 + bj * HALF + 4 * n) : (f32x4){0.f, 0.f, 0.f, 0.f};
#pragma unroll
        for (int ai = 0; ai < 2; ++ai)
#pragma unroll
            for (int m = 0; m < 4; ++m) { bf16_t* rowp = dst + (size_t)(row0 + ai * HALF + m * 16) * 1024 + col0; const float s = rs[ai][m];
#pragma unroll
                for (int bj = 0; bj < 2; ++bj) { f32x4 v0 = acc[ai][bj][m][0] * s, v1 = acc[ai][bj][m][1] * s;
                    if (act) {
#pragma unroll
                        for (int j = 0; j < 4; ++j) { v0[j] = silu_f(v0[j]) * qs; v1[j] = silu_f(v1[j]) * qs; } }
                    if (t == 1) {
#pragma unroll
                        for (int j = 0; j < 4; ++j) { v0[j] = __builtin_amdgcn_logf(lb[bj][0][j] + (1.0f - lb[bj][0][j]) * fast_sigmoid(v0[j])); v1[j] = __builtin_amdgcn_logf(lb[bj][1][j] + (1.0f - lb[bj][1][j]) * fast_sigmoid(v1[j])); } }
                    *(u32x4*)(rowp + bj * HALF) = pack8(v0, v1); } }
    }
};
struct EpiSwiGLU {
    static constexpr bool PERM = true, AFTER_DRAIN = false;
    bf16_t* H; int ldh; const float* rowss;
    __device__ __forceinline__ void operator()(const f32x4 (&acc)[2][2][4][2], const Unit& u, int wr, int wc, int fr, int fq) const {
        const int row0 = u.pm * BM + wr * 64 + fr;
        float rs[2][4];
#pragma unroll
        for (int ai = 0; ai < 2; ++ai)
#pragma unroll
            for (int m = 0; m < 4; ++m) rs[ai][m] = row_rs<16>(rowss, row0 + ai * HALF + m * 16, fq);
        const int col0 = u.pn * HALF + wc * 32 + 8 * fq;
#pragma unroll
        for (int ai = 0; ai < 2; ++ai)
#pragma unroll
            for (int m = 0; m < 4; ++m) { const float s = rs[ai][m], s2 = s * s, cs = -1.44269504089f * s; u32x4 w;
                float hv[8];
#pragma unroll
                for (int j = 0; j < 8; ++j) { const float g = acc[ai][0][m][j >> 2][j & 3], up = acc[ai][1][m][j >> 2][j & 3];
                    hv[j] = (g * up) * s2 * __builtin_amdgcn_rcpf(1.0f + __builtin_amdgcn_exp2f(g * cs)); }
                w.x = pk_native(hv[0], hv[1]); w.y = pk_native(hv[2], hv[3]); w.z = pk_native(hv[4], hv[5]); w.w = pk_native(hv[6], hv[7]);
                *(u32x4*)(H + (size_t)(row0 + ai * HALF + m * 16) * ldh + col0) = w; }
    }
};
template <int NP, bool XF32> struct EpiResid {
    static constexpr bool PERM = true, AFTER_DRAIN = false;
    const float* xin; bf16_t* xb; float* rowss_out; const float* parts_in;
    __device__ __forceinline__ void operator()(const f32x4 (&acc)[2][2][4][2], const Unit& u, int wr, int wc, int fr, int fq) const {
        int lv = threadIdx.x & 63; if constexpr (!XF32) { asm volatile("" : "+v"(lv)); fr = lv & 15; fq = lv >> 4; }
        const int a16 = (lv ^ 16) << 2, a32 = (lv ^ 32) << 2;
        const int row0 = u.pm * BM + wr * 64 + fr, col0 = u.pn * BM + wc * 32 + 8 * fq;
        if constexpr (!XF32) {
            u32x4 xw[2][4][2];
#pragma unroll
            for (int ai = 0; ai < 2; ++ai)
#pragma unroll
                for (int m = 0; m < 4; ++m)
#pragma unroll
                    for (int bj = 0; bj < 2; ++bj) xw[ai][m][bj] = *(const u32x4*)(xb + (size_t)(row0 + ai * HALF + m * 16) * 1024 + col0 + bj * HALF);
            asm volatile("" ::: "memory");
            float rs[2][4];
#pragma unroll
            for (int ai = 0; ai < 2; ++ai) {
#pragma unroll
                for (int m = 0; m < 4; ++m) rs[ai][m] = NP ? row_rs_a<(NP ? NP : 16)>(parts_in, row0 + ai * HALF + m * 16, fq, a16, a32) : 1.0f;
                asm volatile("" ::: "memory"); }
#pragma unroll
            for (int ai = 0; ai < 2; ++ai)
#pragma unroll
                for (int m = 0; m < 4; ++m) { const int row = row0 + ai * HALF + m * 16; const size_t off = (size_t)row * 1024 + col0; const float s = rs[ai][m]; float ss = 0.f;
#pragma unroll
                    for (int bj = 0; bj < 2; ++bj) { const u32x4 w0 = xw[ai][m][bj];
                        const f32x4 x0 = (f32x4){__builtin_bit_cast(float, w0.x << 16), __builtin_bit_cast(float, w0.x & 0xffff0000u), __builtin_bit_cast(float, w0.y << 16), __builtin_bit_cast(float, w0.y & 0xffff0000u)};
                        const f32x4 x1 = (f32x4){__builtin_bit_cast(float, w0.z << 16), __builtin_bit_cast(float, w0.z & 0xffff0000u), __builtin_bit_cast(float, w0.w << 16), __builtin_bit_cast(float, w0.w & 0xffff0000u)};
                        const f32x4 y0 = x0 + acc[ai][bj][m][0] * s, y1 = x1 + acc[ai][bj][m][1] * s;
                        *(u32x4*)(xb + off + bj * HALF) = pack8(y0, y1);
                        ss += ((y0[0] * y0[0] + y0[1] * y0[1]) + (y0[2] * y0[2] + y0[3] * y0[3])) + ((y1[0] * y1[0] + y1[1] * y1[1]) + (y1[2] * y1[2] + y1[3] * y1[3])); }
                    ss += bperm(a16, ss); ss += bperm(a32, ss);
                    if (fq == 0) rowss_out[(size_t)row * 16 + u.pn * 4 + wc] = ss; }
        } else {
        float rs[2][4];
#pragma unroll
        for (int ai = 0; ai < 2; ++ai)
#pragma unroll
            for (int m = 0; m < 4; ++m) rs[ai][m] = NP ? row_rs<(NP ? NP : 16)>(parts_in, row0 + ai * HALF + m * 16, fq) : 1.0f;
#pragma unroll
        for (int ai = 0; ai < 2; ++ai)
#pragma unroll
            for (int m = 0; m < 4; ++m) { const int row = row0 + ai * HALF + m * 16; const size_t off = (size_t)row * 1024 + col0; const float s = rs[ai][m]; float ss = 0.f;
#pragma unroll
                for (int bj = 0; bj < 2; ++bj) { const size_t o2 = off + bj * HALF;
                    const f32x4 x0 = *(const f32x4*)(xin + o2), x1 = *(const f32x4*)(xin + o2 + 4);
                    const f32x4 y0 = x0 + acc[ai][bj][m][0] * s, y1 = x1 + acc[ai][bj][m][1] * s;
                    *(u32x4*)(xb + o2) = pack8(y0, y1);
                    ss += ((y0[0] * y0[0] + y0[1] * y0[1]) + (y0[2] * y0[2] + y0[3] * y0[3])) + ((y1[0] * y1[0] + y1[1] * y1[1]) + (y1[2] * y1[2] + y1[3] * y1[3])); }
                ss += __shfl_xor(ss, 16); ss += __shfl_xor(ss, 32);
                if (fq == 0) rowss_out[(size_t)row * 16 + u.pn * 4 + wc] = ss;
                if (m == 3) asm volatile("" ::: "memory"); }
        }
    }
};
}

constexpr int NWAVES = 8;
constexpr int BATCH = 16, SEQ = 4096, D = 1024, M = BATCH * SEQ;
constexpr int GLA_H = 4, GLA_DK = 128, GLA_DV = 256, GLA_KEY = 512, GLA_IN = 3088, GLA_N = 3584;
constexpr int HG_H = 8, HG_N = 4096;
constexpr int FF = 2816, FF2 = 2 * FF;
constexpr float NORM_EPS = 1e-6f;
#ifndef MK_PER_PHASE
#define MK_PER_PHASE 0
#endif
constexpr int N_PHASES = 14;

constexpr size_t MiB = 1u << 20;
constexpr size_t WS_CTL = 0, CTL_ZERO_BYTES = 64 * 1024;
constexpr size_t WS_W_GLA = 2 * MiB;
constexpr size_t WS_W_O0 = 9 * MiB;
constexpr size_t WS_W_F0I = 11 * MiB;
constexpr size_t WS_W_F0O = 22 * MiB;
constexpr size_t WS_W_HG = 28 * MiB;
constexpr size_t WS_W_O1 = 36 * MiB;
constexpr size_t WS_W_F1I = 38 * MiB;
constexpr size_t WS_W_F1O = 49 * MiB;
constexpr size_t WS_ROWSS = 56 * MiB;
constexpr size_t WS_SSQH = 60 * MiB;
constexpr size_t WS_LBT = 62 * MiB;
constexpr size_t WS_XB = 64 * MiB;
constexpr size_t WS_YB = 192 * MiB;
constexpr size_t WS_P0 = 320 * MiB;
constexpr size_t WS_HB = 320 * MiB;
constexpr size_t WS_SEGL = 832 * MiB;
constexpr size_t WS_SEGB = 856 * MiB;
constexpr size_t WS_END = 857 * MiB;

constexpr int RING_OFF = 0, RING_BYTES = 131072;
constexpr int LDSCTL_OFF = RING_BYTES, MISC_OFF = LDSCTL_OFF + 320;
constexpr int LDS_BYTES = 147456;
static_assert(MISC_OFF + 128 <= LDS_BYTES, "LDS map");

#define GAS __attribute__((address_space(1)))
#define LAS __attribute__((address_space(3)))
typedef unsigned short bf16;
typedef unsigned v4u __attribute__((ext_vector_type(4)));
typedef unsigned v2u __attribute__((ext_vector_type(2)));
typedef float f32x4 __attribute__((ext_vector_type(4)));
typedef short bf16x8 __attribute__((ext_vector_type(8)));
typedef GAS unsigned gu32;
#define RLX_AGENT __ATOMIC_RELAXED, __HIP_MEMORY_SCOPE_AGENT
#define LDS_WAIT() asm volatile("s_waitcnt lgkmcnt(0)" ::: "memory")
#define VM_WAIT() asm volatile("s_waitcnt vmcnt(0)" ::: "memory")
__device__ __forceinline__ unsigned f2bf(float f) { unsigned u = __builtin_bit_cast(unsigned, f); return (u + 0x7fffu + ((u >> 16) & 1u)) >> 16; }
__device__ __forceinline__ unsigned pk2(float lo, float hi) { return f2bf(lo) | (f2bf(hi) << 16); }
__device__ __forceinline__ float bf2f(bf16 b) { return __builtin_bit_cast(float, (unsigned)b << 16); }
#define XB_TMO      128
#define XB_XCNT(j)  (256  + 64 * (j))
#define XB_XSUB(j)  (1280 + 64 * (j))
#define XB_XGEN(j)  (2304 + 64 * (j))
#define XB_TOP      3328
#define XB_TOPGEN   3392
#define XCD_BAR_WORDS 3456
#define XB_SPIN_CAP (1u << 18)

__device__ __forceinline__ unsigned xb_ld(unsigned* p)              { return __hip_atomic_load(p, __ATOMIC_RELAXED, __HIP_MEMORY_SCOPE_AGENT); }
__device__ __forceinline__ unsigned xb_add(unsigned* p, unsigned v) { return __hip_atomic_fetch_add(p, v, __ATOMIC_RELAXED, __HIP_MEMORY_SCOPE_AGENT); }
__device__ __forceinline__ unsigned xb_xcc_id() { return (unsigned)__builtin_amdgcn_s_getreg((3 << 11) | 20) & 0xFu; }
#define XB_SPIN(cond, bar) do { unsigned _sp = 0; while (cond) { __builtin_amdgcn_s_sleep(1); \
    if ((++_sp & 255u) == 0u) { if (xb_ld(&(bar)[XB_TMO])) break; if (_sp > XB_SPIN_CAP) { atomicAdd(&(bar)[XB_TMO], 1u); break; } } } } while (0)

struct XcdBarrier {
    unsigned* bar; unsigned x;
    volatile LAS unsigned* st;
};

__device__ __forceinline__ XcdBarrier xcd_barrier_post(unsigned* bar, volatile LAS unsigned* st) {
    XcdBarrier b; b.bar = bar; b.x = xb_xcc_id(); b.st = st;
    if (threadIdx.x == 0) (void)xb_add(&bar[XB_XCNT(b.x)], 1u);
    return b;
}
__device__ __forceinline__ void xcd_barrier_complete(unsigned* bar, unsigned x, unsigned& nloc, unsigned& nx) {
    const unsigned G = gridDim.x * gridDim.y * gridDim.z;
    unsigned sum, cnt, mine, sp = 0u;
    for (;;) {
        sum = 0u; cnt = 0u; mine = 0u;
#pragma unroll
        for (unsigned j = 0; j < 16; ++j) { const unsigned c = xb_ld(&bar[XB_XCNT(j)]); sum += c; cnt += (c > 0u) ? 1u : 0u; mine = (j == x) ? c : mine; }
        if (sum == G) break;
        __builtin_amdgcn_s_sleep(1);
        if ((++sp & 255u) == 0u) { if (xb_ld(&bar[XB_TMO])) break; if (sp > XB_SPIN_CAP) { atomicAdd(&bar[XB_TMO], 1u); break; } }
    }
    nloc = mine > 0u ? mine : 1u; nx = cnt > 0u ? cnt : 1u;
}

__device__ __forceinline__ void xcd_barrier(const XcdBarrier& b) {
    asm volatile("s_waitcnt vmcnt(0)" ::: "memory");
    __syncthreads();
    if (threadIdx.x == 0) {
        unsigned* bar = b.bar;
        __builtin_amdgcn_s_waitcnt(0);
        unsigned nloc = b.st[0], nx = b.st[1];
        if (nloc == 0u) { xcd_barrier_complete(bar, b.x, nloc, nx); b.st[0] = nloc; b.st[1] = nx; }
        const unsigned old = xb_add(&bar[XB_XSUB(b.x)], 1u);
        const unsigned gen = old / nloc;
        if (old + 1u == (gen + 1u) * nloc) {
            __builtin_amdgcn_fence(__ATOMIC_RELEASE, "agent");
            asm volatile("s_waitcnt vmcnt(0)" ::: "memory");
            const unsigned og = xb_add(&bar[XB_TOP], 1u);
            const unsigned tg = og / nx;
            if (og + 1u == (tg + 1u) * nx) xb_add(&bar[XB_TOPGEN], 1u);
            else XB_SPIN(xb_ld(&bar[XB_TOPGEN]) == tg, bar);
            __builtin_amdgcn_fence(__ATOMIC_ACQUIRE, "agent");
            xb_add(&bar[XB_XGEN(b.x)], 1u);
            asm volatile("s_waitcnt vmcnt(0)" ::: "memory");
        } else {
            XB_SPIN(xb_ld(&bar[XB_XGEN(b.x)]) == gen, bar);
            __builtin_amdgcn_fence(__ATOMIC_ACQUIRE, "agent");
            asm volatile("s_waitcnt vmcnt(0)" ::: "memory");
        }
    }
    __syncthreads();
}

__device__ __forceinline__ float wave_sum(float v) {
#pragma unroll
    for (int o = 1; o < 64; o <<= 1) v += __shfl_xor(v, o);
    return v;
}
__device__ __forceinline__ void p0_gain_load(const float* gain, int k0, int lane, f32x4 (&g)[2]) {
    g[0] = (f32x4){1.f, 1.f, 1.f, 1.f}; g[1] = g[0];
    if (gain) { g[0] = *(const f32x4*)(gain + k0 + 8 * (lane & 7)); g[1] = *(const f32x4*)(gain + k0 + 8 * (lane & 7) + 4); }
}
__device__ __forceinline__ void p0_tile_out(bf16* WT, int Kp, int drow0, int k0, LAS float* scr, int lane, const f32x4 (&g)[2]) {
    const int c = lane & 7;
    LDS_WAIT(); asm volatile("" ::: "memory");
#pragma unroll
    for (int j = 0; j < 4; ++j) { const int n = (lane >> 3) + 8 * j; const LAS float* s = scr + (8 * c) * 33 + n;
        v4u o; o.x = pk2(s[0 * 33] * g[0].x, s[1 * 33] * g[0].y); o.y = pk2(s[2 * 33] * g[0].z, s[3 * 33] * g[0].w); o.z = pk2(s[4 * 33] * g[1].x, s[5 * 33] * g[1].y); o.w = pk2(s[6 * 33] * g[1].z, s[7 * 33] * g[1].w);
        *(GAS v4u*)(WT + (size_t)(drow0 + n) * Kp + k0 + 8 * c) = o; }
    LDS_WAIT(); asm volatile("" ::: "memory");
}
struct P0Item { const float* W; const float* gain; bf16* WT; int ldw, k0, n0, Kp, drow0; };
__device__ __forceinline__ void p0_item_load(const P0Item& t, f32x4 (&w)[8], f32x4 (&g)[2], int lane) {
    const int kr = lane >> 3, nq = lane & 7;
    p0_gain_load(t.gain, t.k0, lane, g);
#pragma unroll
    for (int i = 0; i < 8; ++i) w[i] = *(const f32x4*)(t.W + (size_t)(t.k0 + 8 * i + kr) * t.ldw + t.n0 + 4 * nq);
}
__device__ __forceinline__ void p0_item_finish(const P0Item& t, const f32x4 (&w)[8], const f32x4 (&g)[2], LAS float* scr, int lane) {
    const int kr = lane >> 3, nq = lane & 7;
#pragma unroll
    for (int i = 0; i < 8; ++i) { LAS float* d = scr + (8 * i + kr) * 33 + 4 * nq; d[0] = w[i].x; d[1] = w[i].y; d[2] = w[i].z; d[3] = w[i].w; }
    p0_tile_out(t.WT, t.Kp, t.drow0, t.k0, scr, lane, g);
}
__device__ __forceinline__ void p0_w12_item(const float* Win, const float* Wgu, int k0, int n0, const float* gain, bf16* WT, int drow0, LAS float* scr, int lane) {
    LAS float* w1s = scr + 2304;
    { const f32x4* src = (const f32x4*)(Win + (size_t)(k0 + lane) * GLA_IN + 3072); const f32x4 a0 = src[0], a1 = src[1], a2 = src[2], a3 = src[3];
      LAS f32x4* d = (LAS f32x4*)(w1s + lane * 20); d[0] = a0; d[1] = a1; d[2] = a2; d[3] = a3; }
    float w2[16]; f32x4 g[2]; p0_gain_load(gain, k0, lane, g);
#pragma unroll
    for (int r = 0; r < 16; ++r) w2[r] = Wgu[r * GLA_KEY + n0 + (lane & 31)];
    LDS_WAIT(); asm volatile("" ::: "memory");
#pragma unroll 4
    for (int i = 0; i < 32; ++i) { const int kk = 2 * i + (lane >> 5); const LAS f32x4* w1 = (const LAS f32x4*)(w1s + kk * 20); float s = 0.f;
#pragma unroll
        for (int q = 0; q < 4; ++q) { const f32x4 t = w1[q]; s += (t.x * w2[4 * q] + t.y * w2[4 * q + 1]) + (t.z * w2[4 * q + 2] + t.w * w2[4 * q + 3]); }
        scr[kk * 33 + (lane & 31)] = s; }
    p0_tile_out(WT, D, drow0, k0, scr, lane, g);
}
#define P0_ROWS_LOAD(v, mm) do { _Pragma("unroll") for (int r_ = 0; r_ < 4; ++r_) { const GAS f32x4* xr_ = (const GAS f32x4*)(x + (size_t)((mm) + r_ * rstride) * D) + lane; \
        _Pragma("unroll") for (int j_ = 0; j_ < 4; ++j_) v[r_][j_] = xr_[64 * j_]; } } while (0)
#define P0_ROWS_STORE(v, mm) do { float s_[4]; \
        _Pragma("unroll") for (int r_ = 0; r_ < 4; ++r_) { float t_ = 0.f; \
            _Pragma("unroll") for (int j_ = 0; j_ < 4; ++j_) t_ += (v[r_][j_].x * v[r_][j_].x + v[r_][j_].y * v[r_][j_].y) + (v[r_][j_].z * v[r_][j_].z + v[r_][j_].w * v[r_][j_].w); \
            s_[r_] = wave_sum(t_); } \
        _Pragma("unroll") for (int r_ = 0; r_ < 4; ++r_) { GAS v4u* o_ = (GAS v4u*)(xb + (size_t)((mm) + r_ * rstride) * D) + (lane >> 1) + 32 * (lane & 1); \
            _Pragma("unroll") for (int i_ = 0; i_ < 2; ++i_) { \
                const unsigned a0_ = pk2(v[r_][2 * i_].x, v[r_][2 * i_].y), a1_ = pk2(v[r_][2 * i_].z, v[r_][2 * i_].w), b0_ = pk2(v[r_][2 * i_ + 1].x, v[r_][2 * i_ + 1].y), b1_ = pk2(v[r_][2 * i_ + 1].z, v[r_][2 * i_ + 1].w); \
                const unsigned t0_ = odd_ ? a0_ : b0_, t1_ = odd_ ? a1_ : b1_;                                     \
                const unsigned q0_ = (unsigned)__builtin_amdgcn_mov_dpp((int)t0_, 0xB1, 0xF, 0xF, true), q1_ = (unsigned)__builtin_amdgcn_mov_dpp((int)t1_, 0xB1, 0xF, 0xF, true); \
                v4u w_; if (odd_) { w_.x = q0_; w_.y = q1_; w_.z = b0_; w_.w = b1_; } else { w_.x = a0_; w_.y = a1_; w_.z = q0_; w_.w = q1_; } \
                o_[64 * i_] = w_; } \
            if (lane < 16) rowss[(size_t)((mm) + r_ * rstride) * 16 + lane] = (lane == 0) ? s_[r_] : 0.f; } } while (0)
__device__ __forceinline__ void p0_rows(const float* x, bf16* xb, float* rowss, int m0, int mstep, int rstride, int lane) {
    f32x4 va[4][4], vb[4][4]; const bool odd_ = lane & 1;
    P0_ROWS_LOAD(va, m0);
    for (int m = m0; m < M; m += 2 * mstep) {
        P0_ROWS_LOAD(vb, m + mstep); asm volatile("" ::: "memory");
        P0_ROWS_STORE(va, m); asm volatile("" ::: "memory");
        if (m + 2 * mstep < M) P0_ROWS_LOAD(va, m + 2 * mstep);
        asm volatile("" ::: "memory");
        P0_ROWS_STORE(vb, m + mstep); asm volatile("" ::: "memory");
    }
}
#undef P0_ROWS_LOAD
#undef P0_ROWS_STORE

struct Ptrs {
    const float *x, *mixer_norm, *ffn_norm, *gla_w_in, *gla_w_gu, *gla_b_gate, *gla_head_norm, *gla_w_out, *hg_w_in, *hg_lb, *hg_out_norm, *hg_w_out, *ffn_w_in, *ffn_w_out, *final_norm;
    float* out;
    bf16 *Wgla, *Wo0, *Wf0i, *Wf0o, *Whg, *Wo1, *Wf1i, *Wf1o;
    float *rowss, *ssqh, *segL, *segB, *lbt;
    bf16 *XB, *YB, *HB;
    bf16 *gQ, *gK, *gV, *gR, *gZ;
    bf16 *hQ, *hF, *hV, *hG;
};

namespace p0c {
constexpr int KB1 = D / 64, KB2 = FF / 64;
constexpr int I_GLA = KB1 * (3072 / 32), I_W12 = KB1 * (GLA_KEY / 32), I_O = KB1 * (D / 32), I_FI = KB1 * (FF2 / 32), I_FO = KB2 * (D / 32), I_HG = KB1 * (HG_N / 32);
constexpr int NT = I_GLA + 2 * I_O + 2 * I_FI + 2 * I_FO + I_HG;
}
__device__ __forceinline__ void p0_transposes(const Ptrs& P, LAS float* scr, int lane, int lo, int hi, int w0, int nw) {
    using namespace p0c;
    auto decode = [&](int r, P0Item& t) {
        if (r < I_GLA) { const int nb = r % 96, kb = r / 96; t = P0Item{P.gla_w_in, P.mixer_norm, P.Wgla, GLA_IN, 64 * kb, 32 * nb, D, 32 * nb}; return; } r -= I_GLA;
        if (r < I_O) { const int nb = r % 32, kb = r / 32; t = P0Item{P.gla_w_out, nullptr, P.Wo0, D, 64 * kb, 32 * nb, D, 32 * nb}; return; } r -= I_O;
        if (r < I_O) { const int nb = r % 32, kb = r / 32; t = P0Item{P.hg_w_out, P.hg_out_norm, P.Wo1, D, 64 * kb, 32 * nb, D, 32 * nb}; return; } r -= I_O;
        if (r < 2 * I_FI) { const int l = r / I_FI; r -= l * I_FI; const int nb = r % 176, kb = r / 176, n0 = 32 * nb, bj = n0 / FF, c = n0 % FF;
            t = P0Item{P.ffn_w_in + (size_t)l * D * FF2, P.ffn_norm + l * D, l ? P.Wf1i : P.Wf0i, FF2, 64 * kb, n0, D, 256 * (c / 128) + 128 * bj + (c % 128)}; return; } r -= 2 * I_FI;
        if (r < 2 * I_FO) { const int l = r / I_FO; r -= l * I_FO; const int nb = r % 32, kb = r / 32;
            t = P0Item{P.ffn_w_out + (size_t)l * FF * D, nullptr, l ? P.Wf1o : P.Wf0o, D, 64 * kb, 32 * nb, FF, 32 * nb}; return; } r -= 2 * I_FO;
        { const int nb = r % 128, kb = r / 128; t = P0Item{P.hg_w_in, P.mixer_norm + D, P.Whg, HG_N, 64 * kb, 32 * nb, D, 32 * nb}; }
    };
    if (lo + w0 < hi) {
        P0Item cur, nxt; f32x4 wc[8], wn[8], gc[2], gn[2];
        int it = lo + w0; decode(it, cur); p0_item_load(cur, wc, gc, lane);
        for (;;) {
            const int nit = it + nw; const bool more = nit < hi;
            if (more) { decode(nit, nxt); p0_item_load(nxt, wn, gn, lane); }
            asm volatile("" ::: "memory");
            p0_item_finish(cur, wc, gc, scr, lane);
            if (!more) break;
#pragma unroll
            for (int i = 0; i < 8; ++i) wc[i] = wn[i];
            gc[0] = gn[0]; gc[1] = gn[1]; cur = nxt; it = nit;
        }
    }
}
__device__ __forceinline__ void p0_prologue(const Ptrs& P, LAS unsigned char* lds, int wave, int lane, int G) {
    using namespace p0c;
    LAS float* scr = (LAS float*)(lds + RING_OFF + wave * 16384);
    const int gw = blockIdx.x * NWAVES + wave, NGW = G * NWAVES;
    for (int it = gw; it < I_W12; it += NGW) { const int nb = it % 16, kb = it / 16; p0_w12_item(P.gla_w_in, P.gla_w_gu, 64 * kb, 32 * nb, P.mixer_norm, P.Wgla, 3072 + 32 * nb, scr, lane); }
    p0_transposes(P, scr, lane, 0, I_GLA, (gw + NGW - I_W12) % NGW, NGW);
    if (gw < 16) { const int c = gw * 64 + lane; const float l0 = P.hg_lb[c], l1 = P.hg_lb[D + c], mx = fmaxf(l0, l1), e0 = __expf(l0 - mx), e1 = __expf(l1 - mx); P.lbt[c] = e1 / (e0 + e1); }
    p0_rows(P.x, P.XB, P.rowss, gw, 4 * NGW, NGW, lane);
}
__device__ __forceinline__ void p2_weight_helpers(const Ptrs& P, LAS unsigned char* lds, int wave, int lane, int G, int nunits) {
    using namespace p0c;
    LAS float* scr = (LAS float*)(lds + RING_OFF + wave * 16384);
    const int idle = G > nunits ? G - nunits : 0;
    if (idle > 0) { if ((int)blockIdx.x >= nunits) p0_transposes(P, scr, lane, I_GLA, NT, ((int)blockIdx.x - nunits) * NWAVES + wave, idle * NWAVES); }
    else p0_transposes(P, scr, lane, I_GLA, NT, (int)blockIdx.x * NWAVES + wave, G * NWAVES);
}

__device__ __forceinline__ void final_norm_rows(const Ptrs& P, int wave, int lane, int G) {
    const int gw = blockIdx.x * NWAVES + wave, NGW = G * NWAVES, mstep = 4 * NGW;
    f32x4 g[4];
#pragma unroll
    for (int j = 0; j < 4; ++j) g[j] = ((const f32x4*)P.final_norm)[lane + 64 * j];
#define FN_LOAD(WQ, SPQ, mm) do { _Pragma("unroll") for (int r_ = 0; r_ < 4; ++r_) { const size_t mr_ = (size_t)((mm) + r_ * NGW); SPQ[r_] = P.rowss[mr_ * 16 + (lane & 15)]; const v2u* xr_ = (const v2u*)(P.XB + mr_ * D) + lane; \
        _Pragma("unroll") for (int j_ = 0; j_ < 4; ++j_) WQ[r_][j_] = xr_[64 * j_]; } } while (0)
#define FN_STORE(WQ, SPQ, mm) do { _Pragma("unroll") for (int r_ = 0; r_ < 4; ++r_) { float s_ = SPQ[r_]; s_ += __shfl_xor(s_, 1); s_ += __shfl_xor(s_, 2); s_ += __shfl_xor(s_, 4); s_ += __shfl_xor(s_, 8); \
        const float rs_ = 1.0f / sqrtf(s_ * (1.0f / 1024.0f) + NORM_EPS); f32x4* orow_ = (f32x4*)(P.out + (size_t)((mm) + r_ * NGW) * D) + lane; \
        _Pragma("unroll") for (int j_ = 0; j_ < 4; ++j_) { const v2u q_ = WQ[r_][j_]; \
            const f32x4 v_ = {bf2f((bf16)(q_.x & 0xffffu)), bf2f((bf16)(q_.x >> 16)), bf2f((bf16)(q_.y & 0xffffu)), bf2f((bf16)(q_.y >> 16))}; orow_[64 * j_] = v_ * rs_ * g[j_]; } } } while (0)
    v2u wa[4][4], wb[4][4]; float spa[4], spb[4];
    FN_LOAD(wa, spa, gw);
    for (int m = gw; m < M; m += 2 * mstep) {
        FN_LOAD(wb, spb, m + mstep); asm volatile("" ::: "memory");
        FN_STORE(wa, spa, m); asm volatile("" ::: "memory");
        if (m + 2 * mstep < M) FN_LOAD(wa, spa, m + 2 * mstep);
        asm volatile("" ::: "memory");
        FN_STORE(wb, spb, m + mstep); asm volatile("" ::: "memory");
    }
#undef FN_LOAD
#undef FN_STORE
}

namespace cs {
typedef short s16x4 __attribute__((ext_vector_type(4)));
typedef float f32x16 __attribute__((ext_vector_type(16)));
typedef __bf16 bf16v2 __attribute__((ext_vector_type(2)));
constexpr int A2_OFF = 0, O_OFF = 0, K2_OFF = 34816, V_OFF = 67584, P_OFF = 100352, PSZ = 9216, TOT_OFF = 118784, CV_OFF = 126976, GAIN_OFF = 130048;
constexpr float LOG2E = 1.44269504089f;
constexpr int NSEG = 4, SEG_CH = SEQ / 64 / NSEG;
__device__ __forceinline__ unsigned off_b(unsigned row, unsigned ch) { return 2048u * (row >> 3) + 512u * (ch >> 2) + 64u * (row & 7u) + 16u * ((ch & 3u) ^ ((row >> 2) & 3u)); }
__device__ __forceinline__ unsigned off_p(unsigned i, unsigned ch) { return 144u * i + 16u * ch; }
__device__ __forceinline__ unsigned off_o(unsigned i, unsigned ch) { return 528u * i + 16u * ch; }
__device__ __forceinline__ unsigned tr_addr(unsigned lane, unsigned c, unsigned ks, unsigned t) {
    const unsigned h = lane >> 5, blk = (lane >> 4) & 1u, q = (lane & 15u) >> 2, p = lane & 3u;
    return off_b(16u * ks + 8u * h + 4u * t + q, 4u * c + 2u * blk + (p >> 1)) + 8u * (p & 1u);
}
__device__ __forceinline__ s16x4 tr_read(LAS unsigned char* p) { return __builtin_amdgcn_ds_read_tr16_b64_v4i16((LAS s16x4*)p); }
__device__ __forceinline__ unsigned pkb(float a, float b) { bf16v2 v = {(__bf16)a, (__bf16)b}; return __builtin_bit_cast(unsigned, v); }
__device__ __forceinline__ float blo(unsigned u) { return __builtin_bit_cast(float, u << 16); }
__device__ __forceinline__ float bhi(unsigned u) { return __builtin_bit_cast(float, u & 0xffff0000u); }
__device__ __forceinline__ bf16x8 cat8(s16x4 lo, s16x4 hi) { return __builtin_shufflevector(lo, hi, 0, 1, 2, 3, 4, 5, 6, 7); }
__device__ __forceinline__ void wave_pair(const f32x4& tot, f32x4& lo, f32x4& wt) {
#pragma unroll
    for (int e = 0; e < 4; ++e) { float a = tot[e], b = tot[e];
        asm("v_permlane32_swap_b32 %0, %1" : "+v"(a), "+v"(b));
        lo[e] = a; wt[e] = a + b; }
}
#define CS_MFMA32(a, b, c) __builtin_amdgcn_mfma_f32_32x32x16_bf16((a), (b), (c), 0, 0, 0)
#define CS_MFMA16(a, b, c) __builtin_amdgcn_mfma_f32_16x16x32_bf16((a), (b), (c), 0, 0, 0)

template <bool HG>
__device__ __forceinline__ void scan_chunk_unit(const Ptrs& P, LAS unsigned char* lds, const int tid, const int u, const int seg) {
    constexpr int SETS = HG ? 2 : 1, TPS = 512 / SETS, TG = TPS / 32, NT = 64 / TG;
    constexpr int PQ = HG ? 1024 : 512, NCH = SEG_CH;
    const int lane = tid & 63, wave = __builtin_amdgcn_readfirstlane(tid >> 6);
    const int b = u >> 2, hq = u & 3;
    const int set = HG ? (wave >> 2) : 0, wset = HG ? (wave & 3) : wave;
    const int ts = tid & (TPS - 1), dq = ts & 31, tg = ts >> 5;
    const int qkcol = (HG ? (2 * hq + set) : hq) * 128 + 4 * dq, vcol0 = hq * 256;
    const int dqs = (dq & ~3) | (((dq & 3) == 1) ? 2 : ((dq & 3) == 2) ? 1 : (dq & 3));
    const int r = lane & 31, h = lane >> 5, vhalf = wave >> 2, vc = wave & 3;
    const int orow = tid >> 3, ocg = tid & 7;
    const size_t row0 = (size_t)b * SEQ + (size_t)seg * (SEG_CH * 64);
    const char* Qn = (const char*)((HG ? P.hQ : P.gQ) + row0 * PQ); const char* Kn = (const char*)((HG ? P.hF : P.gK) + row0 * PQ); const char* Zn = (const char*)(P.gZ + row0 * PQ);
    const char* Vn = (const char*)((HG ? P.hV : P.gV) + row0 * 1024); const char* Gn = (const char*)((HG ? P.hG : P.gR) + row0 * 1024); char* Yn = (char*)(P.YB + row0 * 1024);
    float* SSn = P.ssqh + row0 * 8;
    const unsigned A2s = A2_OFF + set * 16384, K2s = K2_OFF + set * 16384;
#define CS_BASES_PREP(tv) const int lane_ = (tv) & 63, ts_ = (tv) & (TPS - 1), dq_ = ts_ & 31, tg_ = ts_ >> 5, orow_ = (tv) >> 3, ocg_ = (tv) & 7; \
    const int dqs_ = (dq_ & ~3) | (((dq_ & 3) == 1) ? 2 : ((dq_ & 3) == 2) ? 1 : (dq_ & 3)); \
    const unsigned vqk = (unsigned)((tg_ * NT) * PQ + (HG ? (2 * hq + set) : hq) * 128 + 4 * dq_) * 2u, vrow = (unsigned)(orow_ * 1024 + vcol0 + 32 * ocg_) * 2u, vrowV = (unsigned)(orow_ * 1024 + vcol0 + 8 * ocg_) * 2u; \
    const unsigned wA2 = A2s + off_b(tg_ * NT, dq_ >> 1) + 8 * (dq_ & 1), wK2 = K2s + off_b(tg_ * NT, dqs_ >> 1) + 8 * (dqs_ & 1); \
    const unsigned wA2b = A2s + off_b(tg_ * NT + 4, dq_ >> 1) + 8 * (dq_ & 1), wK2b = K2s + off_b(tg_ * NT + 4, dqs_ >> 1) + 8 * (dqs_ & 1); \
    const unsigned TOTw = TOT_OFF + (set * (TG * 64) + wset * 128 + 4 * dq_) * 4, TOTr = TOT_OFF + (set * (TG * 64) + 4 * dq_) * 4, CVw = CV_OFF + (set * 384 + 4 * dqs_) * 4; \
    const unsigned xV = (orow_ >> 2) & 3, wV = V_OFF + 2048 * (orow_ >> 3) + 64 * (orow_ & 7) + 512 * (ocg_ >> 2) + 16 * ((ocg_ & 3) ^ xV);     (void)lane_; (void)wA2b; (void)wK2b
#define CS_BASES_MMA(tv) const int lm_ = (tv) & 63, r_ = lm_ & 31, h_ = lm_ >> 5; \
    const unsigned CVr = CV_OFF + (set * 384 + 4 * h_) * 4; \
    const unsigned rA2[2] = {A2s + off_b(r_, h_), A2s + off_b(r_, 2 + h_)}; \
    const unsigned rV[2] = {V_OFF + vhalf * 16384 + tr_addr(lm_, vc, 0, 0), V_OFF + vhalf * 16384 + tr_addr(lm_, vc, 0, 1)}; \
    const unsigned rK[2] = {K2s + tr_addr(lm_, 0, 0, 0), K2s + tr_addr(lm_, 0, 0, 1)}; \
    const unsigned rP = P_OFF + set * PSZ + 144 * r_ + 16 * h_, wO = O_OFF + 528 * r_ + 64 * wave + 8 * h_; \
    const int ic = lm_ & 15, g = lm_ >> 4; \
    const unsigned tK = off_b(ic, g), tA0 = off_b(ic, 2 * (g >> 1)) + 8 * (g & 1), tA1 = off_b(ic, 2 * (g >> 1) + 1) + 8 * (g & 1), tP = 144 * ic + 16 * (g >> 1) + 8 * (g & 1)
#define CS_BASES_OUT(tv) const int orow_ = (tv) >> 3, ocg_ = (tv) & 7; const unsigned vrowV = (unsigned)(orow_ * 1024 + vcol0 + 8 * ocg_) * 2u, rO = O_OFF + 528 * orow_ + 16 * ocg_
    if (!HG) { if (tid < 256) ((LAS float*)(lds + GAIN_OFF))[tid] = P.gla_head_norm[tid]; }
    f32x16 S[4];
#pragma unroll
    for (int dt = 0; dt < 4; ++dt)
#pragma unroll
        for (int i = 0; i < 16; ++i) S[dt][i] = 0.f;
    for (int sp = 0; sp < seg; ++sp) {
        const float* Lp = P.segL + ((size_t)(u * (NSEG - 1) + sp) * 8 + wave) * 4096 + lane;
        const float* Bp = P.segB + (size_t)((u * (NSEG - 1) + sp) * 2 + set) * 128 + 4 * h;
#pragma unroll
        for (int dt = 0; dt < 4; ++dt)
#pragma unroll
            for (int g4 = 0; g4 < 4; ++g4) { const f32x4 bt = *(const f32x4*)(Bp + 32 * dt + 8 * g4);
#pragma unroll
                for (int e = 0; e < 4; ++e) S[dt][4 * g4 + e] = __builtin_amdgcn_exp2f(bt[e]) * S[dt][4 * g4 + e] + Lp[(dt * 16 + 4 * g4 + e) * 64]; }
    }
    v2u pq[NT], pk[NT], pz[NT]; v4u pv[4], pg[4];
#define CS_LOAD_QK() do { _Pragma("unroll") for (int i_ = 0; i_ < NT; ++i_) { pq[i_] = *(const v2u*)(Qn + i_ * PQ * 2 + vqk); pk[i_] = *(const v2u*)(Kn + i_ * PQ * 2 + vqk); if (!HG) pz[i_] = *(const v2u*)(Zn + i_ * PQ * 2 + vqk); } } while (0)
#define CS_LOAD_V() do { _Pragma("unroll") for (int c_ = 0; c_ < 4; ++c_) pv[c_] = *(const v4u*)(Vn + vrowV + 128 * c_); } while (0)
#define CS_LOAD_G() do { _Pragma("unroll") for (int c_ = 0; c_ < 4; ++c_) pg[c_] = *(const v4u*)(Gn + vrowV + 128 * c_); } while (0)
    { int tv0 = tid; asm volatile("" : "+v"(tv0)); CS_BASES_PREP(tv0); (void)wA2; (void)wK2; (void)TOTw; (void)TOTr; (void)CVw; (void)wV; (void)xV; (void)vrow; CS_LOAD_QK(); CS_LOAD_V(); }
    f32x4 c2log = {0.f, 0.f, 0.f, 0.f};
    for (int n = 0; n < NCH; ++n) {
        int tv1 = tid; asm volatile("" : "+v"(tv1));
        CS_BASES_PREP(tv1);
        CS_LOAD_G();
        float p[NT][4];
#pragma unroll
        for (int i = 0; i < NT; ++i) {
            float lg[4];
            if (HG) { lg[0] = blo(pk[i].x); lg[1] = bhi(pk[i].x); lg[2] = blo(pk[i].y); lg[3] = bhi(pk[i].y);
                pk[i].x = pkb(1.0f - __builtin_amdgcn_exp2f(lg[0]), 1.0f - __builtin_amdgcn_exp2f(lg[1])); pk[i].y = pkb(1.0f - __builtin_amdgcn_exp2f(lg[2]), 1.0f - __builtin_amdgcn_exp2f(lg[3])); }
            else { lg[0] = blo(pz[i].x); lg[1] = bhi(pz[i].x); lg[2] = blo(pz[i].y); lg[3] = bhi(pz[i].y); }
#pragma unroll
            for (int e = 0; e < 4; ++e) p[i][e] = (i ? p[i - 1][e] : 0.f) + lg[e];
        }
        f32x4 glo, gwt; wave_pair((f32x4){p[NT - 1][0], p[NT - 1][1], p[NT - 1][2], p[NT - 1][3]}, glo, gwt);
        *(LAS f32x4*)(lds + TOTw) = gwt;
        __syncthreads();
        {
            f32x4 before = (lane_ >= 32) ? glo : (f32x4){0.f, 0.f, 0.f, 0.f}, bmid = {0.f, 0.f, 0.f, 0.f}, blast = bmid;
#pragma unroll
            for (int gg = 0; gg < TG / 2; ++gg) { const f32x4 t = *(const LAS f32x4*)(lds + TOTr + gg * 512); blast += t; if (gg < TG / 4) bmid += t; if (gg < wset) before += t; }
#pragma unroll
            for (int i = 0; i < NT; ++i) {
                const float qv[4] = {blo(pq[i].x), bhi(pq[i].x), blo(pq[i].y), bhi(pq[i].y)}, kv[4] = {blo(pk[i].x), bhi(pk[i].x), blo(pk[i].y), bhi(pk[i].y)};
                float a2[4], k2[4];
#pragma unroll
                for (int e = 0; e < 4; ++e) { const float bb = before[e] + p[i][e] - bmid[e]; a2[e] = qv[e] * __builtin_amdgcn_exp2f(bb); k2[e] = kv[e] * __builtin_amdgcn_exp2f(-bb); }
                *(LAS v2u*)(lds + (i < 4 ? wA2 + 64 * i : wA2b + 64 * (i - 4))) = (v2u){pkb(a2[0], a2[1]), pkb(a2[2], a2[3])};
                *(LAS v2u*)(lds + (i < 4 ? wK2 + 64 * i : wK2b + 64 * (i - 4))) = (v2u){pkb(k2[0], k2[1]), pkb(k2[2], k2[3])}; asm volatile("" ::: "memory"); }
            if (tg_ == 0) { f32x4 cf;
#pragma unroll
                for (int e = 0; e < 4; ++e) cf[e] = __builtin_amdgcn_exp2f(c2log[e] + bmid[e]);
                *(LAS f32x4*)(lds + CVw) = cf; }
            c2log = blast - bmid;
#pragma unroll
            for (int c = 0; c < 4; ++c) *(LAS v4u*)(lds + wV + 16384 * (c >> 1) + 1024 * (c & 1)) = pv[c];
        }
        __syncthreads();
        Qn += 64 * PQ * 2; Kn += 64 * PQ * 2; Zn += 64 * PQ * 2; Vn += 64 * 2048;
        if (n + 1 < NCH) { CS_LOAD_QK(); CS_LOAD_V(); }
        int tv2 = tid; asm volatile("" : "+v"(tv2));
        CS_BASES_MMA(tv2);
        f32x16 o0, o1;
#pragma unroll
        for (int i = 0; i < 16; ++i) { o0[i] = 0.f; o1[i] = 0.f; }
#pragma unroll
        for (int dt = 0; dt < 4; ++dt)
#pragma unroll
            for (int s = 0; s < 2; ++s) {
                const f32x4 ca = *(const LAS f32x4*)(lds + CVr + (32 * dt + 16 * s) * 4), cb = *(const LAS f32x4*)(lds + CVr + (32 * dt + 16 * s + 8) * 4);
#pragma unroll
                for (int j = 0; j < 4; ++j) { S[dt][8 * s + j] *= ca[j]; S[dt][8 * s + 4 + j] *= cb[j]; }
                v4u sw; sw.x = pkb(S[dt][8 * s + 0], S[dt][8 * s + 1]); sw.y = pkb(S[dt][8 * s + 2], S[dt][8 * s + 3]);
                sw.z = pkb(S[dt][8 * s + 4], S[dt][8 * s + 5]); sw.w = pkb(S[dt][8 * s + 6], S[dt][8 * s + 7]);
                const bf16x8 sf = __builtin_bit_cast(bf16x8, sw);
                const bf16x8 a0 = *(const LAS bf16x8*)(lds + rA2[s] + 512 * dt), a1 = *(const LAS bf16x8*)(lds + rA2[s] + 512 * dt + 8192);
                o0 = CS_MFMA32(sf, a0, o0); o1 = CS_MFMA32(sf, a1, o1);
                asm volatile("" ::: "memory");
            }
        for (int task = wave; task < 12 * SETS; task += 8) {
            const int pset = HG ? (task >= 12 ? 1 : 0) : 0, tt = task - 12 * pset;
            int it, jt;
            if (tt < 10) { it = (tt >= 6) ? 3 : (tt >= 3) ? 2 : (tt >= 1) ? 1 : 0; jt = tt - (it * (it + 1)) / 2; } else { it = (tt == 10) ? 0 : 2; jt = it + 1; }
            const unsigned A2p = A2_OFF + pset * 16384 + 4096 * it, K2p = K2_OFF + pset * 16384 + 4096 * jt + tK, Pp = P_OFF + pset * PSZ + 144 * 16 * it + 32 * jt + tP;
            f32x4 acc = {0.f, 0.f, 0.f, 0.f};
            if (tt < 10) {
#pragma unroll
                for (int s = 0; s < 4; ++s) {
                    const bf16x8 ka = *(const LAS bf16x8*)(lds + K2p + 512 * s);
                    const s16x4 lo = *(const LAS s16x4*)(lds + A2p + tA0 + 512 * s), hi = *(const LAS s16x4*)(lds + A2p + tA1 + 512 * s);
                    acc = CS_MFMA16(ka, cat8(lo, hi), acc);
                }
                if (jt == it) {
#pragma unroll
                    for (int e = 0; e < 4; ++e) if (4 * g + e > ic) acc[e] = 0.f; }
            }
            *(LAS v2u*)(lds + Pp) = (v2u){pkb(acc[0], acc[1]), pkb(acc[2], acc[3])};
        }
        __syncthreads();
        bf16x8 vf[4];
#pragma unroll
        for (int ks = 0; ks < 4; ++ks) vf[ks] = cat8(tr_read(lds + rV[0] + 4096 * ks), tr_read(lds + rV[1] + 4096 * ks));
#pragma unroll
        for (int ks = 0; ks < 2; ++ks) o0 = CS_MFMA32(vf[ks], *(const LAS bf16x8*)(lds + rP + 32 * ks), o0);
#pragma unroll
        for (int ks = 0; ks < 4; ++ks) o1 = CS_MFMA32(vf[ks], *(const LAS bf16x8*)(lds + rP + 32 * ks + 4608), o1);
#pragma unroll
        for (int g4 = 0; g4 < 4; ++g4) {
            *(LAS v2u*)(lds + wO + 16 * g4) = (v2u){pkb(o0[4 * g4], o0[4 * g4 + 1]), pkb(o0[4 * g4 + 2], o0[4 * g4 + 3])};
            *(LAS v2u*)(lds + wO + 16 * g4 + 16896) = (v2u){pkb(o1[4 * g4], o1[4 * g4 + 1]), pkb(o1[4 * g4 + 2], o1[4 * g4 + 3])};
        }
asm volatile("" ::: "memory");
#pragma unroll
        for (int dt = 0; dt < 4; ++dt) {
#pragma unroll
            for (int ks = 0; ks < 4; ++ks) S[dt] = CS_MFMA32(cat8(tr_read(lds + rK[0] + 512 * dt + 4096 * ks), tr_read(lds + rK[1] + 512 * dt + 4096 * ks)), vf[ks], S[dt]);
            asm volatile("" ::: "memory");
        }
        __syncthreads();
        {
            int tv3 = tid; asm volatile("" : "+v"(tv3));
            CS_BASES_OUT(tv3);
            float ov[32]; float ss = 0.f, ss1 = 0.f;
#pragma unroll
            for (int c = 0; c < 4; ++c) { const v4u w = *(const LAS v4u*)(lds + rO + 128 * c);
                ov[8 * c + 0] = blo(w.x); ov[8 * c + 1] = bhi(w.x); ov[8 * c + 2] = blo(w.y); ov[8 * c + 3] = bhi(w.y); ov[8 * c + 4] = blo(w.z); ov[8 * c + 5] = bhi(w.z); ov[8 * c + 6] = blo(w.w); ov[8 * c + 7] = bhi(w.w); }
#pragma unroll
            for (int i = 0; i < 16; ++i) { ss += ov[i] * ov[i]; ss1 += ov[16 + i] * ov[16 + i]; }
            float inv = 1.0f;
            if (HG) { ss += __shfl_xor(ss, 1); ss1 += __shfl_xor(ss1, 1); ss += __shfl_xor(ss, 2); ss1 += __shfl_xor(ss1, 2); ss += __shfl_xor(ss, 4); ss1 += __shfl_xor(ss1, 4);
                if (ocg_ < 2) SSn[orow_ * 8 + 2 * hq + ocg_] = ocg_ ? ss1 : ss; }
            else { ss += ss1; ss += __shfl_xor(ss, 1); ss += __shfl_xor(ss, 2); ss += __shfl_xor(ss, 4); inv = __builtin_amdgcn_rsqf(ss * (1.0f / 256.0f) + NORM_EPS); }
#pragma unroll
            for (int c = 0; c < 4; ++c) {
                const float gt[8] = {blo(pg[c].x), bhi(pg[c].x), blo(pg[c].y), bhi(pg[c].y), blo(pg[c].z), bhi(pg[c].z), blo(pg[c].w), bhi(pg[c].w)};
                float y[8];
                if (HG) {
#pragma unroll
                    for (int e = 0; e < 8; ++e) y[e] = ov[8 * c + e] * gt[e]; }
                else { const f32x4 ga = *(const LAS f32x4*)(lds + GAIN_OFF + 4 * (8 * ocg_ + 64 * c)), gb = *(const LAS f32x4*)(lds + GAIN_OFF + 4 * (8 * ocg_ + 64 * c + 4));
#pragma unroll
                    for (int e = 0; e < 4; ++e) { y[e] = ov[8 * c + e] * inv * ga[e] * gt[e]; y[4 + e] = ov[8 * c + 4 + e] * inv * gb[e] * gt[4 + e]; } }
                *(v4u*)(Yn + vrowV + 128 * c) = (v4u){pkb(y[0], y[1]), pkb(y[2], y[3]), pkb(y[4], y[5]), pkb(y[6], y[7])};
                asm volatile("" ::: "memory");
            }
        }
        Gn += 64 * 2048; Yn += 64 * 2048; SSn += 64 * 8;
    }
    __syncthreads();
#undef CS_LOAD_QK
#undef CS_BASES_PREP
#undef CS_BASES_MMA
#undef CS_BASES_OUT
#undef CS_LOAD_V
#undef CS_LOAD_G
}

template <bool HG>
__device__ __forceinline__ void scan_state_unit(const Ptrs& P, LAS unsigned char* lds, const int tid, const int u, const int seg) {
    constexpr int SETS = HG ? 2 : 1, TPS = 512 / SETS, TG = TPS / 32, NT = 64 / TG;
    constexpr int PQ = HG ? 1024 : 512;
    const int lane = tid & 63, wave = __builtin_amdgcn_readfirstlane(tid >> 6);
    const int b = u >> 2, hq = u & 3;
    const int set = HG ? (wave >> 2) : 0, wset = HG ? (wave & 3) : wave;
    const int vcol0 = hq * 256, vhalf = wave >> 2, vc = wave & 3;
    const size_t rowl = (size_t)b * SEQ + (size_t)seg * (SEG_CH * 64) + (SEG_CH - 1) * 64;
    const char* Kn = (const char*)((HG ? P.hF : P.gK) + rowl * PQ); const char* Zn = (const char*)(P.gZ + rowl * PQ); const char* Vn = (const char*)((HG ? P.hV : P.gV) + rowl * 1024);
    const unsigned K2s = K2_OFF + set * 16384;
#define CS_BASES_PREP(tv) const int ts_ = (tv) & (TPS - 1), dq_ = ts_ & 31, tg_ = ts_ >> 5, orow_ = (tv) >> 3, ocg_ = (tv) & 7; \
    const int dqs_ = (dq_ & ~3) | (((dq_ & 3) == 1) ? 2 : ((dq_ & 3) == 2) ? 1 : (dq_ & 3)); \
    const unsigned vqk = (unsigned)((tg_ * NT) * PQ + (HG ? (2 * hq + set) : hq) * 128 + 4 * dq_) * 2u, vrow = (unsigned)(orow_ * 1024 + vcol0 + 32 * ocg_) * 2u, vrowV = (unsigned)(orow_ * 1024 + vcol0 + 8 * ocg_) * 2u; \
    const unsigned wK2 = K2s + off_b(tg_ * NT, dqs_ >> 1) + 8 * (dqs_ & 1), wK2b = K2s + off_b(tg_ * NT + 4, dqs_ >> 1) + 8 * (dqs_ & 1); \
    const unsigned TOTw = TOT_OFF + (set * (TG * 64) + wset * 128 + 4 * dq_) * 4, TOTr = TOT_OFF + (set * (TG * 64) + 4 * dq_) * 4; \
    const unsigned xV = (orow_ >> 2) & 3, wV = V_OFF + 2048 * (orow_ >> 3) + 64 * (orow_ & 7) + 512 * (ocg_ >> 2) + 16 * ((ocg_ & 3) ^ xV);     (void)wK2b
    f32x16 S[4];
#pragma unroll
    for (int dt = 0; dt < 4; ++dt)
#pragma unroll
        for (int i = 0; i < 16; ++i) S[dt][i] = 0.f;
    f32x4 R = {0.f, 0.f, 0.f, 0.f};
    v2u pkA[NT], pzA[NT], pkB[NT], pzB[NT]; v4u pvA[4], pvB[4];
#define CS_LOAD_K(pk, pz) do { _Pragma("unroll") for (int i_ = 0; i_ < NT; ++i_) { pk[i_] = *(const v2u*)(Kn + i_ * PQ * 2 + vqk); if (!HG) pz[i_] = *(const v2u*)(Zn + i_ * PQ * 2 + vqk); } } while (0)
#define CS_LOAD_V(pv) do { _Pragma("unroll") for (int c_ = 0; c_ < 4; ++c_) pv[c_] = *(const v4u*)(Vn + vrowV + 128 * c_); } while (0)
#define CS_STEP_BACK() do { Kn -= 64 * PQ * 2; Zn -= 64 * PQ * 2; Vn -= 64 * 2048; } while (0)
    { int tv0 = tid; asm volatile("" : "+v"(tv0)); CS_BASES_PREP(tv0); (void)wK2; (void)TOTw; (void)TOTr; (void)wV; (void)xV;
      CS_LOAD_K(pkA, pzA); CS_LOAD_V(pvA); CS_STEP_BACK(); CS_LOAD_K(pkB, pzB); CS_LOAD_V(pvB); CS_STEP_BACK(); }
#define CS_STATE_CHUNK(pk, pz, pv, more) do { \
        int tv1 = tid; asm volatile("" : "+v"(tv1)); \
        CS_BASES_PREP(tv1); \
        float p[NT][4]; \
        _Pragma("unroll") for (int i = 0; i < NT; ++i) { \
            float lg[4]; \
            if (HG) { lg[0] = blo(pk[i].x); lg[1] = bhi(pk[i].x); lg[2] = blo(pk[i].y); lg[3] = bhi(pk[i].y); \
                pk[i].x = pkb(1.0f - __builtin_amdgcn_exp2f(lg[0]), 1.0f - __builtin_amdgcn_exp2f(lg[1])); pk[i].y = pkb(1.0f - __builtin_amdgcn_exp2f(lg[2]), 1.0f - __builtin_amdgcn_exp2f(lg[3])); } \
            else { lg[0] = blo(pz[i].x); lg[1] = bhi(pz[i].x); lg[2] = blo(pz[i].y); lg[3] = bhi(pz[i].y); } \
            _Pragma("unroll") for (int e = 0; e < 4; ++e) p[i][e] = (i ? p[i - 1][e] : 0.f) + lg[e]; \
        } \
        f32x4 glo, gwt; wave_pair((f32x4){p[NT - 1][0], p[NT - 1][1], p[NT - 1][2], p[NT - 1][3]}, glo, gwt); \
        *(LAS f32x4*)(lds + TOTw) = gwt; \
        __syncthreads();        \
        { \
            f32x4 before = ((tv1 & 63) >= 32) ? glo : (f32x4){0.f, 0.f, 0.f, 0.f}, blast = {0.f, 0.f, 0.f, 0.f}; \
            _Pragma("unroll") for (int gg = 0; gg < TG / 2; ++gg) { const f32x4 t = *(const LAS f32x4*)(lds + TOTr + gg * 512); blast += t; if (gg < wset) before += t; } \
            _Pragma("unroll") for (int i = 0; i < NT; ++i) { \
                const float kv[4] = {blo(pk[i].x), bhi(pk[i].x), blo(pk[i].y), bhi(pk[i].y)}; float k3[4]; \
                _Pragma("unroll") for (int e = 0; e < 4; ++e) k3[e] = kv[e] * __builtin_amdgcn_exp2f(blast[e] - before[e] - p[i][e] + R[e]); \
                *(LAS v2u*)(lds + (i < 4 ? wK2 + 64 * i : wK2b + 64 * (i - 4))) = (v2u){pkb(k3[0], k3[1]), pkb(k3[2], k3[3])}; } \
            R += blast; \
            _Pragma("unroll") for (int c = 0; c < 4; ++c) *(LAS v4u*)(lds + wV + 16384 * (c >> 1) + 1024 * (c & 1)) = pv[c]; \
        } \
        __syncthreads(); \
        if (more) { CS_LOAD_K(pk, pz); CS_LOAD_V(pv); CS_STEP_BACK(); } \
        int tv2 = tid; asm volatile("" : "+v"(tv2)); \
        const int lm_ = tv2 & 63; \
        const unsigned rV[2] = {V_OFF + vhalf * 16384 + tr_addr(lm_, vc, 0, 0), V_OFF + vhalf * 16384 + tr_addr(lm_, vc, 0, 1)}; \
        const unsigned rK[2] = {K2s + tr_addr(lm_, 0, 0, 0), K2s + tr_addr(lm_, 0, 0, 1)}; \
        bf16x8 vf[4]; \
        _Pragma("unroll") for (int ks = 0; ks < 4; ++ks) vf[ks] = cat8(tr_read(lds + rV[0] + 4096 * ks), tr_read(lds + rV[1] + 4096 * ks)); \
        _Pragma("unroll") for (int dt = 0; dt < 4; ++dt) { \
            _Pragma("unroll") for (int ks = 0; ks < 4; ++ks) S[dt] = CS_MFMA32(cat8(tr_read(lds + rK[0] + 512 * dt + 4096 * ks), tr_read(lds + rK[1] + 512 * dt + 4096 * ks)), vf[ks], S[dt]); \
            asm volatile("" ::: "memory"); \
        } \
    } while (0)
    static_assert(SEG_CH % 2 == 0, "the state pass takes two chunks per trip");
    for (int n = 0; n < SEG_CH; n += 2) {
        const bool more = (n + 2 < SEG_CH);
        CS_STATE_CHUNK(pkA, pzA, pvA, more);
        CS_STATE_CHUNK(pkB, pzB, pvB, more);
    }
#undef CS_STATE_CHUNK
#undef CS_STEP_BACK
    {
        float* Lp = P.segL + ((size_t)(u * (NSEG - 1) + seg) * 8 + wave) * 4096 + lane;
#pragma unroll
        for (int dt = 0; dt < 4; ++dt)
#pragma unroll
            for (int i = 0; i < 16; ++i) Lp[(dt * 16 + i) * 64] = S[dt][i];
        const int ts = tid & (TPS - 1), dq = ts & 31, tg = ts >> 5, dqs = (dq & ~3) | (((dq & 3) == 1) ? 2 : ((dq & 3) == 2) ? 1 : (dq & 3));
        if (tg == 0) *(f32x4*)(P.segB + (size_t)((u * (NSEG - 1) + seg) * 2 + set) * 128 + 4 * dqs) = R;
    }
    __syncthreads();
#undef CS_BASES_PREP
#undef CS_LOAD_K
#undef CS_LOAD_V
}
}
struct Args { const float* in[15]; float* out; unsigned char* ws; int ph_lo, ph_hi, li, pad; };
__global__ void __launch_bounds__(NWAVES * 64, 2) fwd(Args args) {
    extern __shared__ __attribute__((aligned(16))) unsigned char lds_raw[];
    LAS unsigned char* lds = (LAS unsigned char*)lds_raw;
    volatile LAS unsigned* MISC = (volatile LAS unsigned*)(lds + MISC_OFF);
    const int tid = threadIdx.x, lane = tid & 63, wave = __builtin_amdgcn_readfirstlane(tid >> 6), G = gridDim.x;
    unsigned char* ws = args.ws;
    Ptrs P;
    P.x = args.in[0]; P.mixer_norm = args.in[1]; P.ffn_norm = args.in[2]; P.gla_w_in = args.in[3]; P.gla_w_gu = args.in[4]; P.gla_b_gate = args.in[5]; P.gla_head_norm = args.in[6]; P.gla_w_out = args.in[7];
    P.hg_w_in = args.in[8]; P.hg_lb = args.in[9]; P.hg_out_norm = args.in[10]; P.hg_w_out = args.in[11]; P.ffn_w_in = args.in[12]; P.ffn_w_out = args.in[13]; P.final_norm = args.in[14]; P.out = args.out;
    P.Wgla = (bf16*)(ws + WS_W_GLA); P.Wo0 = (bf16*)(ws + WS_W_O0); P.Wf0i = (bf16*)(ws + WS_W_F0I); P.Wf0o = (bf16*)(ws + WS_W_F0O); P.Whg = (bf16*)(ws + WS_W_HG); P.Wo1 = (bf16*)(ws + WS_W_O1); P.Wf1i = (bf16*)(ws + WS_W_F1I); P.Wf1o = (bf16*)(ws + WS_W_F1O);
    P.rowss = (float*)(ws + WS_ROWSS); P.ssqh = (float*)(ws + WS_SSQH); P.segL = (float*)(ws + WS_SEGL); P.segB = (float*)(ws + WS_SEGB); P.lbt = (float*)(ws + WS_LBT); P.XB = (bf16*)(ws + WS_XB); P.YB = (bf16*)(ws + WS_YB); P.HB = (bf16*)(ws + WS_HB);
    P.gQ = (bf16*)(ws + WS_P0); P.gK = (bf16*)(ws + WS_P0 + 64 * MiB); P.gV = (bf16*)(ws + WS_P0 + 128 * MiB); P.gR = (bf16*)(ws + WS_P0 + 256 * MiB); P.gZ = (bf16*)(ws + WS_P0 + 384 * MiB);
    P.hQ = (bf16*)(ws + WS_P0); P.hF = (bf16*)(ws + WS_P0 + 128 * MiB); P.hV = (bf16*)(ws + WS_P0 + 256 * MiB); P.hG = (bf16*)(ws + WS_P0 + 384 * MiB);
    for (int u = tid; u < (LDS_BYTES - LDSCTL_OFF) / 4; u += NWAVES * 64) ((LAS unsigned*)(lds + LDSCTL_OFF))[u] = 0u;
    __syncthreads();
    XcdBarrier bar; bar.bar = (unsigned*)(ws + WS_CTL); bar.x = 0; bar.st = nullptr;
    if (!MK_PER_PHASE) bar = xcd_barrier_post((unsigned*)(ws + WS_CTL), MISC + 8);
#define GRID_BAR() do { if (!MK_PER_PHASE) xcd_barrier(bar); } while (0)
    const int lo = args.ph_lo, hi = args.ph_hi;
#define IN(k) (lo <= (k) && (k) < hi)
#define BOTH(k) (IN(k) && IN((k) + 1))

    if (IN(0)) { p0_prologue(P, lds, wave, lane, G); if (BOTH(0)) GRID_BAR(); }
    typedef pg8::EpiResid<0, true> RESID_F32IN; typedef pg8::EpiResid<0, false> RESID_BF; typedef pg8::EpiResid<8, false> RESID_BF8;
#define GEMM_PHASE(k, EPI, AOP, BOP, NN, KK, ...) if (IN(k)) { \
        pg8::Gemm g{AOP, BOP, M, NN, KK}; pg8::StaticOrder S; S.init(M, NN, G, (int)blockIdx.x); EPI E{__VA_ARGS__}; \
        pg8::gemm_phase<EPI, pg8::StaticOrder, PG8_ALIGN, PG8_SP2>(lds + RING_OFF, g, S, E); if (BOTH(k)) GRID_BAR(); }
#define SCAN_PHASE(k, FN, HGF, NUNITS) if (IN(k)) { \
        for (int w = blockIdx.x; w < (NUNITS); w += G) cs::FN<HGF>(P, lds, tid, w & 63, w >> 6); if (BOTH(k)) GRID_BAR(); }
    GEMM_PHASE(1, pg8::EpiProjGLA, P.XB, P.Wgla, GLA_N, D, P.gQ, P.gK, P.gV, P.gR, P.gZ, P.rowss, P.gla_b_gate)
    if (IN(2)) { for (int w = blockIdx.x; w < 64 * (cs::NSEG - 1); w += G) cs::scan_state_unit<false>(P, lds, tid, w & 63, w >> 6);
        p2_weight_helpers(P, lds, wave, lane, G, 64 * (cs::NSEG - 1)); if (BOTH(2)) GRID_BAR(); }
    SCAN_PHASE(3, scan_chunk_unit, false, 64 * cs::NSEG)
    GEMM_PHASE(4, RESID_F32IN, P.YB, P.Wo0, D, D, P.x, P.XB, P.rowss, nullptr)
    GEMM_PHASE(5, pg8::EpiSwiGLU, P.XB, P.Wf0i, FF2, D, P.HB, FF, P.rowss)
    GEMM_PHASE(6, RESID_BF, P.HB, P.Wf0o, D, FF, nullptr, P.XB, P.rowss, nullptr)
    GEMM_PHASE(7, pg8::EpiProjHG, P.XB, P.Whg, HG_N, D, P.hQ, P.hF, P.hV, P.hG, P.rowss, P.lbt)
    SCAN_PHASE(8, scan_state_unit, true, 64 * (cs::NSEG - 1))
    SCAN_PHASE(9, scan_chunk_unit, true, 64 * cs::NSEG)
    GEMM_PHASE(10, RESID_BF8, P.YB, P.Wo1, D, D, nullptr, P.XB, P.rowss, P.ssqh)
    GEMM_PHASE(11, pg8::EpiSwiGLU, P.XB, P.Wf1i, FF2, D, P.HB, FF, P.rowss)
    GEMM_PHASE(12, RESID_BF, P.HB, P.Wf1o, D, FF, nullptr, P.XB, P.rowss, nullptr)
    if (IN(13)) final_norm_rows(P, wave, lane, G);
#undef GEMM_PHASE
#undef SCAN_PHASE
#undef IN
#undef BOTH
}

extern "C" void kernel_launch(void* const* d_in, const int* in_sizes, int n_in, void* d_out, int out_size, void* d_ws, size_t ws_size, hipStream_t stream) {
    static int grid = 0;
    if (grid == 0) {
        if (n_in != 15 || in_sizes[0] != M * D || out_size != M * D || ws_size < WS_END) { fprintf(stderr, "kernel_launch: unexpected shapes (n_in %d, in0 %d, out %d, ws %zu)\n", n_in, n_in > 0 ? in_sizes[0] : -1, out_size, ws_size); grid = -1; return; }
        int dev = 0, cus = 0, per_cu = 0;
        if (hipGetDevice(&dev) != hipSuccess || hipDeviceGetAttribute(&cus, hipDeviceAttributeMultiprocessorCount, dev) != hipSuccess) { grid = -1; return; }
        if (hipFuncSetAttribute((const void*)fwd, hipFuncAttributeMaxDynamicSharedMemorySize, LDS_BYTES) != hipSuccess) { fprintf(stderr, "kernel_launch: hipFuncSetAttribute failed\n"); grid = -1; return; }
        if (hipOccupancyMaxActiveBlocksPerMultiprocessor(&per_cu, (const void*)fwd, NWAVES * 64, LDS_BYTES) != hipSuccess || per_cu < 1) fprintf(stderr, "kernel_launch: occupancy query reports %d\n", per_cu);
        (void)hipGetLastError();
        grid = 256; while (grid > cus) grid >>= 1;
    }
    if (grid < 0) return;
    if (hipMemsetAsync((char*)d_ws + WS_CTL, 0, CTL_ZERO_BYTES, stream) != hipSuccess) return;
    Args a{};
    for (int i = 0; i < 15; ++i) a.in[i] = (const float*)d_in[i];
    a.out = (float*)d_out; a.ws = (unsigned char*)d_ws;
#if MK_PER_PHASE
    for (int k = 0; k < N_PHASES; ++k) { a.ph_lo = k; a.ph_hi = k + 1; a.li = k;
        hipLaunchKernelGGL(fwd, dim3(grid), dim3(NWAVES * 64), LDS_BYTES, stream, a);
    }
#else
    a.ph_lo = 0; a.ph_hi = N_PHASES; a.li = 0;
    hipLaunchKernelGGL(fwd, dim3(grid), dim3(NWAVES * 64), LDS_BYTES, stream, a);
#endif
}
```

```cpp
#include <hip/hip_runtime.h>
#include <cstdio>
#include <cstdint>
#ifndef PG8_SP2
#define PG8_SP2 true
#endif
#ifndef PG8_ALIGN
#define PG8_ALIGN true
#endif
#ifndef PG8_WGM
#define PG8_WGM 8
#endif
#define MK_PER_PHASE 0
namespace pg8 {
#define PG8_LAS __attribute__((address_space(3)))
typedef unsigned short bf16_t;
typedef short bf16x8 __attribute__((ext_vector_type(8)));
typedef float f32x4 __attribute__((ext_vector_type(4)));
typedef unsigned u32x4 __attribute__((ext_vector_type(4)));
constexpr int BM = 256, BK = 64, HALF = 128, HTB = HALF * BK * 2  , STAGE_BYTES = 8 * HTB, NXCD = 8, WGM = PG8_WGM;

__host__ __device__ __forceinline__ int lds_byte(int r, int c) { const int st = (r >> 4) * 2 + (c >> 5), rr = r & 15, cc = c & 31, ob = rr * 64 + cc * 2; return st * 1024 + (ob ^ (((ob >> 9) & 1) << 5)); }
__host__ __device__ __forceinline__ void stage_rc(int b, int& R, int& C) { const int st = b / 1024, sb = b % 1024, swz = sb ^ (((sb >> 9) & 1) << 5); R = (st >> 1) * 16 + swz / 64; C = (st & 1) * 32 + (swz % 64) / 2; }
__host__ __device__ __forceinline__ int perm32(int rho) { const int n = rho >> 4, i = rho & 15; return 8 * (i >> 2) + 4 * n + (i & 3); }

struct Unit { int pm, pn; };
struct Gemm { const bf16_t* A; const bf16_t* Bt; int M, N, K; };

struct StaticOrder {
    int nM, nN, nwg, G, c;
    __host__ __device__ void init(int M, int N, int G_, int c_) { nM = M / BM; nN = N / BM; nwg = nM * nN; G = G_; c = c_; }
    __host__ __device__ bool next(int i, Unit& u) const {
        const long L = (long)i * G + c; if (L >= nwg) return false;
        int wgid = (int)L; { const int q = nwg / NXCD, r = nwg % NXCD, xcd = wgid % NXCD, off = wgid / NXCD; wgid = (xcd < r ? xcd * (q + 1) : r * (q + 1) + (xcd - r) * q) + off; }
        const int nig = WGM * nN, gid = wgid / nig, fm = gid * WGM, gsz = (nM - fm) < WGM ? (nM - fm) : WGM;
        u.pm = fm + ((wgid % nig) % gsz); u.pn = (wgid % nig) / gsz; return true;
    }
    __device__ __forceinline__ void a_ready(const Unit&) const {}
    __device__ __forceinline__ void done(const Unit&) const {}
};
__device__ __forceinline__ unsigned cvt_pk_bf16(float lo, float hi) { unsigned r; asm volatile("v_cvt_pk_bf16_f32 %0, %1, %2" : "=v"(r) : "v"(lo), "v"(hi)); return r; }
typedef float f32x2 __attribute__((ext_vector_type(2)));
template <class Epi, class Sched, bool ALIGN_EPI = false, bool SP2 = false>
__device__ __forceinline__ void gemm_phase(PG8_LAS unsigned char* lds, const Gemm g, const Sched& S, const Epi& E) {
    const int tid = threadIdx.x, wid = __builtin_amdgcn_readfirstlane(tid >> 6), lane = tid & 63, wr = wid >> 2, wc = wid & 3, fr = lane & 15, fq = lane >> 4;
    const int K = g.K, nt = K / BK;
    unsigned voffA[2], voffB[2];
#pragma unroll
    for (int i = 0; i < 2; ++i) { int R, C; stage_rc(tid * 16 + i * 8192, R, C); const int Rb = Epi::PERM ? ((R & ~31) + perm32(R & 31)) : R;
        voffA[i] = Epi::A_TILED ? (unsigned)(((R >> 4) * (K >> 5) + (C >> 5)) * 1024 + (R & 15) * 64 + (C & 31) * 2) : (unsigned)(R * K + C) * 2u;
        voffB[i] = Epi::B_TILED ? (unsigned)(((R >> 4) * (K >> 5) + (C >> 5)) * 1024 + (R & 15) * 64 + (C & 31) * 2) : (unsigned)(Rb * K + C) * 2u; }
    const size_t kstepA = Epi::A_TILED ? (size_t)2048 : (size_t)(BK * 2), kstepB = Epi::B_TILED ? (size_t)2048 : (size_t)(BK * 2);
    const size_t hstep = (size_t)HALF * K * 2;
    const size_t tstep = 2 * hstep;
    const unsigned ldsw = (unsigned)wid * 1024u;
    const int aoff = lds_byte(wr * 64 + fr, fq * 8), boff = lds_byte(wc * 32 + fr, fq * 8);
#define PG8_SA(b, h) (((b) * 2 + (h)) * HTB)
#define PG8_SB(b, h) ((4 + (b) * 2 + (h)) * HTB)
#define PG8_STAGE(bufoff, gbase, voff) do { _Pragma("unroll") for (int _i = 0; _i < 2; ++_i) \
        __builtin_amdgcn_global_load_lds((const unsigned*)((const char*)(gbase) + (voff)[_i]), (PG8_LAS unsigned*)(lds + (bufoff) + ldsw + _i * 8192), 16, 0, 0); } while (0)
#define PG8_LDA(dst, b, h) do { _Pragma("unroll") for (int m = 0; m < 4; ++m) _Pragma("unroll") for (int k = 0; k < 2; ++k) dst[m][k] = *(const PG8_LAS bf16x8*)(lds + PG8_SA(b, h) + aoff + m * 2048 + k * 1024); } while (0)
#define PG8_LDB(dst, b, h) do { _Pragma("unroll") for (int n = 0; n < 2; ++n) _Pragma("unroll") for (int k = 0; k < 2; ++k) dst[n][k] = *(const PG8_LAS bf16x8*)(lds + PG8_SB(b, h) + boff + n * 2048 + k * 1024); } while (0)
#define PG8_MMA(ai, bj, At, Bt) do { __builtin_amdgcn_s_setprio(1); _Pragma("unroll") for (int m = 0; m < 4; ++m) _Pragma("unroll") for (int n = 0; n < 2; ++n) _Pragma("unroll") for (int k = 0; k < 2; ++k) \
        acc[ai][bj][m][n] = __builtin_amdgcn_mfma_f32_16x16x32_bf16(Bt[n][k], At[m][k], acc[ai][bj][m][n], 0, 0, 0); __builtin_amdgcn_s_setprio(0); } while (0)
#define PG8_WAIT_V(n) asm volatile("s_waitcnt vmcnt(" #n ")" ::: "memory")
#define PG8_WAIT_L(n) asm volatile("s_waitcnt lgkmcnt(" #n ")" ::: "memory")
#define PG8_BAR __builtin_amdgcn_s_barrier()
#define PG8_SCHED __builtin_amdgcn_sched_barrier(0)
    Unit cur, nxt; int ui = 0;
    if (!S.next(0, cur)) return;
    f32x4 acc[2][2][4][2];
#pragma unroll
    for (int a = 0; a < 2; ++a)
#pragma unroll
        for (int b = 0; b < 2; ++b)
#pragma unroll
            for (int m = 0; m < 4; ++m)
#pragma unroll
                for (int n = 0; n < 2; ++n) acc[a][b][m][n] = (f32x4){0.f, 0.f, 0.f, 0.f};
    bf16x8 At[4][2], B0[2][2], B1[2][2];
    const char* cA = (const char*)g.A + (size_t)cur.pm * tstep; const char* cB = (const char*)g.Bt + (size_t)cur.pn * tstep;
    S.a_ready(cur);
    if constexpr (SP2) {
        PG8_STAGE(PG8_SB(0, 0), cB, voffB); PG8_STAGE(PG8_SB(0, 1), cB + hstep, voffB); PG8_STAGE(PG8_SA(0, 0), cA, voffA); PG8_STAGE(PG8_SA(0, 1), cA + hstep, voffA);
        if (wr == 1) PG8_BAR;
        PG8_WAIT_V(2); PG8_BAR;
        PG8_STAGE(PG8_SB(1, 0), cB + kstepB, voffB); PG8_STAGE(PG8_SA(1, 0), cA + kstepA, voffA); PG8_STAGE(PG8_SB(1, 1), cB + hstep + kstepB, voffB);
        PG8_WAIT_V(6); PG8_BAR;
    } else {
        PG8_STAGE(PG8_SB(0, 0), cB, voffB); PG8_STAGE(PG8_SA(0, 0), cA, voffA); PG8_STAGE(PG8_SB(0, 1), cB + hstep, voffB); PG8_STAGE(PG8_SA(0, 1), cA + hstep, voffA);
        if (wr == 1) PG8_BAR;
        PG8_WAIT_V(4); PG8_BAR;
        PG8_STAGE(PG8_SB(1, 0), cB + kstepB, voffB); PG8_STAGE(PG8_SA(1, 0), cA + kstepA, voffA); PG8_STAGE(PG8_SB(1, 1), cB + hstep + kstepB, voffB);
        PG8_WAIT_V(6); PG8_BAR;
    }
    for (;;) {
        const bool has_next = S.next(ui + 1, nxt);
        const char* nA = has_next ? (const char*)g.A + (size_t)nxt.pm * tstep : cA; const char* nB = has_next ? (const char*)g.Bt + (size_t)nxt.pn * tstep : cB;
        for (int t = 0; t < nt; t += 2) {
            const bool last = (t == nt - 2);
            const char* a1 = cA + (size_t)(t + 1) * kstepA;
            const char* a2 = last ? nA : cA + (size_t)(t + 2) * kstepA; const char* b2 = last ? nB : cB + (size_t)(t + 2) * kstepB;
            const char* a3 = a2 + kstepA; const char* b3 = b2 + kstepB;
            if (last && has_next) S.a_ready(nxt);
            if constexpr (SP2) {
            PG8_LDB(B0, 0, 0); PG8_LDB(B1, 0, 1); PG8_SCHED; PG8_LDA(At, 0, 0); PG8_STAGE(PG8_SA(1, 1), a1 + hstep, voffA);
            PG8_WAIT_V(8); PG8_WAIT_L(0); PG8_BAR; PG8_MMA(0, 0, At, B0); PG8_MMA(0, 1, At, B1); PG8_BAR; PG8_SCHED;
            PG8_LDA(At, 0, 1); PG8_STAGE(PG8_SB(0, 0), b2, voffB); PG8_STAGE(PG8_SB(0, 1), b2 + hstep, voffB); PG8_STAGE(PG8_SA(0, 0), a2, voffA);
            PG8_WAIT_V(8); PG8_WAIT_L(0); PG8_BAR; PG8_MMA(1, 0, At, B0); PG8_MMA(1, 1, At, B1); PG8_BAR; PG8_SCHED;
            PG8_LDB(B0, 1, 0); PG8_LDB(B1, 1, 1); PG8_SCHED; PG8_LDA(At, 1, 0); PG8_STAGE(PG8_SA(0, 1), a2 + hstep, voffA);
            PG8_WAIT_V(8); PG8_WAIT_L(0); PG8_BAR; PG8_MMA(0, 0, At, B0); PG8_MMA(0, 1, At, B1); PG8_BAR; PG8_SCHED;
            PG8_LDA(At, 1, 1); PG8_STAGE(PG8_SB(1, 0), b3, voffB); PG8_STAGE(PG8_SB(1, 1), b3 + hstep, voffB); PG8_STAGE(PG8_SA(1, 0), a3, voffA);
            PG8_WAIT_V(8); PG8_WAIT_L(0); PG8_BAR; PG8_MMA(1, 0, At, B0); PG8_MMA(1, 1, At, B1); PG8_BAR; PG8_SCHED;
            } else {
            PG8_LDB(B0, 0, 0); PG8_SCHED; PG8_LDA(At, 0, 0); PG8_STAGE(PG8_SA(1, 1), a1 + hstep, voffA);
            PG8_WAIT_L(8); PG8_BAR; PG8_WAIT_L(0); PG8_MMA(0, 0, At, B0); PG8_BAR; PG8_SCHED;
            PG8_LDB(B1, 0, 1); PG8_STAGE(PG8_SB(0, 0), b2, voffB);
            PG8_BAR; PG8_WAIT_L(0); PG8_MMA(0, 1, At, B1); PG8_BAR;
            PG8_LDA(At, 0, 1); PG8_STAGE(PG8_SA(0, 0), a2, voffA);
            PG8_BAR; PG8_WAIT_L(0); PG8_MMA(1, 0, At, B0); PG8_BAR; PG8_SCHED;
            PG8_STAGE(PG8_SB(0, 1), b2 + hstep, voffB);
            PG8_WAIT_V(6); PG8_BAR; PG8_MMA(1, 1, At, B1); PG8_BAR;
            PG8_LDB(B0, 1, 0); PG8_SCHED; PG8_LDA(At, 1, 0); PG8_STAGE(PG8_SA(0, 1), a2 + hstep, voffA);
            PG8_WAIT_L(8); PG8_BAR; PG8_WAIT_L(0); PG8_MMA(0, 0, At, B0); PG8_BAR; PG8_SCHED;
            PG8_LDB(B1, 1, 1); PG8_STAGE(PG8_SB(1, 0), b3, voffB);
            PG8_BAR; PG8_WAIT_L(0); PG8_MMA(0, 1, At, B1); PG8_BAR;
            PG8_LDA(At, 1, 1); PG8_STAGE(PG8_SA(1, 0), a3, voffA);
            PG8_BAR; PG8_WAIT_L(0); PG8_MMA(1, 0, At, B0); PG8_BAR; PG8_SCHED;
            PG8_STAGE(PG8_SB(1, 1), b3 + hstep, voffB);
            PG8_WAIT_V(6); PG8_BAR; PG8_MMA(1, 1, At, B1); PG8_BAR;
            }
        }
        if constexpr (ALIGN_EPI) { if (wr == 0) PG8_BAR; }
        if constexpr (!Epi::AFTER_DRAIN) { E(acc, cur, wr, wc, fr, fq); S.done(cur); }
        if (!has_next) break;
#pragma unroll
        for (int a = 0; a < 2; ++a)
#pragma unroll
            for (int b = 0; b < 2; ++b)
#pragma unroll
                for (int m = 0; m < 4; ++m)
#pragma unroll
                    for (int n = 0; n < 2; ++n) acc[a][b][m][n] = (f32x4){0.f, 0.f, 0.f, 0.f};
        cur = nxt; cA = nA; cB = nB; ++ui;
        if constexpr (ALIGN_EPI) { if (wr == 1) PG8_BAR; }
    }
    PG8_WAIT_V(0);
    if constexpr (!ALIGN_EPI) { if (wr == 0) PG8_BAR; }
    PG8_BAR;
    if constexpr (Epi::AFTER_DRAIN) { E.fused(acc, cur, wr, wc, fr, fq, lds, wid, lane); S.done(cur); }
#undef PG8_SA
#undef PG8_SB
#undef PG8_STAGE
#undef PG8_LDA
#undef PG8_LDB
#undef PG8_MMA
#undef PG8_WAIT_V
#undef PG8_WAIT_L
#undef PG8_BAR
#undef PG8_SCHED
}
}

namespace pg8 {
typedef unsigned u32x2 __attribute__((ext_vector_type(2)));
constexpr float NORM_EPS = 1e-6f;
__device__ __forceinline__ float fast_sigmoid(float x) { return __builtin_amdgcn_rcpf(1.0f + __builtin_amdgcn_exp2f(-1.44269504089f * x)); }
__device__ __forceinline__ float silu_f(float x) { return x * fast_sigmoid(x); }
template <int NP> __device__ __forceinline__ float row_rs(const float* parts, int row, int fq) {
    f32x4 v = (f32x4){0.f, 0.f, 0.f, 0.f};
    if (4 * fq < NP) v = *(const f32x4*)(parts + (size_t)row * NP + 4 * fq);
    float s = (v[0] + v[1]) + (v[2] + v[3]); s += __shfl_xor(s, 16); s += __shfl_xor(s, 32);
    return __builtin_amdgcn_rsqf(s * (1.0f / 1024.0f) + NORM_EPS);
}
__device__ __forceinline__ float bperm(int addr, float v) { return __builtin_bit_cast(float, __builtin_amdgcn_ds_bpermute(addr, __builtin_bit_cast(int, v))); }
template <int NP> __device__ __forceinline__ float row_rs_a(const float* parts, int row, int fq, int a16, int a32) {
    f32x4 v = (f32x4){0.f, 0.f, 0.f, 0.f};
    if (4 * fq < NP) v = *(const f32x4*)(parts + (size_t)row * NP + 4 * fq);
    float s = (v[0] + v[1]) + (v[2] + v[3]); s += bperm(a16, s); s += bperm(a32, s);
    return __builtin_amdgcn_rsqf(s * (1.0f / 1024.0f) + NORM_EPS);
}
typedef __bf16 bf16v2_t __attribute__((ext_vector_type(2)));
__device__ __forceinline__ unsigned pk_native(float a, float b) { bf16v2_t v = {(__bf16)a, (__bf16)b}; return __builtin_bit_cast(unsigned, v); }
__device__ __forceinline__ u32x4 pack8(const f32x4& a, const f32x4& b) { u32x4 w; w.x = pk_native(a[0], a[1]); w.y = pk_native(a[2], a[3]); w.z = pk_native(b[0], b[1]); w.w = pk_native(b[2], b[3]); return w; }

__device__ __forceinline__ float log2_decay_gla(float z) { return (fminf(z, 0.f) * 1.44269504089f - __builtin_amdgcn_logf(1.0f + __builtin_amdgcn_exp2f(-1.44269504089f * fabsf(z)))) * (1.0f / 16.0f); }
struct EpiProjGLA {
    static constexpr bool PERM = true, AFTER_DRAIN = false, A_TILED = false, B_TILED = false;
    bf16_t *Q, *K, *V, *R, *Z; const float* rowss; const float* bgate;
    __device__ __forceinline__ void operator()(const f32x4 (&acc)[2][2][4][2], const Unit& u, int wr, int wc, int fr, int fq) const {
        const int row0 = u.pm * BM + wr * 64 + fr;
        float rs[2][4];
#pragma unroll
        for (int ai = 0; ai < 2; ++ai)
#pragma unroll
            for (int m = 0; m < 4; ++m) rs[ai][m] = row_rs<16>(rowss, row0 + ai * HALF + m * 16, fq);
        const int pn = u.pn; bf16_t* dst; int ldc, colt, mode;
        if (pn < 2) { dst = Q; ldc = 512; colt = pn * 256; mode = 0; } else if (pn < 4) { dst = K; ldc = 512; colt = (pn - 2) * 256; mode = 1; }
        else if (pn < 8) { dst = V; ldc = 1024; colt = (pn - 4) * 256; mode = 1; } else if (pn < 12) { dst = R; ldc = 1024; colt = (pn - 8) * 256; mode = 2; }
        else { dst = Z; ldc = 512; colt = (pn - 12) * 256; mode = 3; }
        const int col0 = colt + wc * 32 + 8 * fq;
        f32x4 bv[2][2];
#pragma unroll
        for (int bj = 0; bj < 2; ++bj)
#pragma unroll
            for (int n = 0; n < 2; ++n) bv[bj][n] = (mode == 3) ? *(const f32x4*)(bgate + col0 + bj * HALF + 4 * n) : (f32x4){0.f, 0.f, 0.f, 0.f};
        const float qs = (mode == 0) ? 0.08838834764831845f : 1.0f;
#pragma unroll
        for (int ai = 0; ai < 2; ++ai)
#pragma unroll
            for (int m = 0; m < 4; ++m) { bf16_t* rowp = dst + (size_t)(row0 + ai * HALF + m * 16) * ldc + col0; const float s = rs[ai][m] * qs;
#pragma unroll
                for (int bj = 0; bj < 2; ++bj) { f32x4 v0 = acc[ai][bj][m][0] * s + bv[bj][0], v1 = acc[ai][bj][m][1] * s + bv[bj][1];
                    if (mode == 2) {
#pragma unroll
                        for (int j = 0; j < 4; ++j) { v0[j] = silu_f(v0[j]); v1[j] = silu_f(v1[j]); } }
                    if (mode == 3) {
#pragma unroll
                        for (int j = 0; j < 4; ++j) { v0[j] = log2_decay_gla(v0[j]); v1[j] = log2_decay_gla(v1[j]); } }
                    *(u32x4*)(rowp + bj * HALF) = pack8(v0, v1); } }
    }
};
struct EpiProjHG {
    static constexpr bool PERM = true, AFTER_DRAIN = false, A_TILED = false, B_TILED = false;
    bf16_t *Q, *F, *V, *G; const float* rowss; const float* lbt;
    __device__ __forceinline__ void operator()(const f32x4 (&acc)[2][2][4][2], const Unit& u, int wr, int wc, int fr, int fq) const {
        const int row0 = u.pm * BM + wr * 64 + fr;
        float rs[2][4];
#pragma unroll
        for (int ai = 0; ai < 2; ++ai)
#pragma unroll
            for (int m = 0; m < 4; ++m) rs[ai][m] = row_rs<16>(rowss, row0 + ai * HALF + m * 16, fq);
        const int pn = u.pn, t = pn >> 2; bf16_t* dst = (t == 0) ? Q : (t == 1) ? F : (t == 2) ? V : G;
        const bool act = (t == 0) || (t == 3); const float qs = (t == 0) ? 0.08838834764831845f : 1.0f;
        const int col0 = (pn & 3) * 256 + wc * 32 + 8 * fq;
        f32x4 lb[2][2];
#pragma unroll
        for (int bj = 0; bj < 2; ++bj)
#pragma unroll
            for (int n = 0; n < 2; ++n) lb[bj][n] = (t == 1) ? *(const f32x4*)(lbt + col0 + bj * HALF + 4 * n) : (f32x4){0.f, 0.f, 0.f, 0.f};
#pragma unroll
        for (int ai = 0; ai < 2; ++ai)
#pragma unroll
            for (int m = 0; m < 4; ++m) { bf16_t* rowp = dst + (size_t)(row0 + ai * HALF + m * 16) * 1024 + col0; const float s = rs[ai][m];
#pragma unroll
                for (int bj = 0; bj < 2; ++bj) { f32x4 v0 = acc[ai][bj][m][0] * s, v1 = acc[ai][bj][m][1] * s;
                    if (act) {
#pragma unroll
                        for (int j = 0; j < 4; ++j) { v0[j] = silu_f(v0[j]) * qs; v1[j] = silu_f(v1[j]) * qs; } }
                    if (t == 1) {
#pragma unroll
                        for (int j = 0; j < 4; ++j) { v0[j] = __builtin_amdgcn_logf(lb[bj][0][j] + (1.0f - lb[bj][0][j]) * fast_sigmoid(v0[j])); v1[j] = __builtin_amdgcn_logf(lb[bj][1][j] + (1.0f - lb[bj][1][j]) * fast_sigmoid(v1[j])); } }
                    *(u32x4*)(rowp + bj * HALF) = pack8(v0, v1); } }
    }
};
struct EpiSwiGLU {
    static constexpr bool PERM = true, AFTER_DRAIN = false, A_TILED = false, B_TILED = false;
    bf16_t* H; int ldh; const float* rowss;
    __device__ __forceinline__ void operator()(const f32x4 (&acc)[2][2][4][2], const Unit& u, int wr, int wc, int fr, int fq) const {
        const int row0 = u.pm * BM + wr * 64 + fr;
        float rs[2][4];
#pragma unroll
        for (int ai = 0; ai < 2; ++ai)
#pragma unroll
            for (int m = 0; m < 4; ++m) rs[ai][m] = row_rs<16>(rowss, row0 + ai * HALF + m * 16, fq);
        const int col0 = u.pn * HALF + wc * 32 + 8 * fq;
#pragma unroll
        for (int ai = 0; ai < 2; ++ai)
#pragma unroll
            for (int m = 0; m < 4; ++m) { const float s = rs[ai][m], s2 = s * s, cs = -1.44269504089f * s; u32x4 w;
                float hv[8];
#pragma unroll
                for (int j = 0; j < 8; ++j) { const float g = acc[ai][0][m][j >> 2][j & 3], up = acc[ai][1][m][j >> 2][j & 3];
                    hv[j] = (g * up) * s2 * __builtin_amdgcn_rcpf(1.0f + __builtin_amdgcn_exp2f(g * cs)); }
                w.x = pk_native(hv[0], hv[1]); w.y = pk_native(hv[2], hv[3]); w.z = pk_native(hv[4], hv[5]); w.w = pk_native(hv[6], hv[7]);
                *(u32x4*)(H + ((size_t)(((row0 - fr) >> 4) + ai * 8 + m) * (ldh >> 5) + (u.pn * 4 + wc)) * 512 + fr * 32 + fq * 8) = w; }
    }
};
template <int NP, bool XF32, bool ATILE = false> struct EpiResid {
    static constexpr bool PERM = true, AFTER_DRAIN = false, A_TILED = ATILE, B_TILED = false;
    const float* xin; bf16_t* xb; float* rowss_out; const float* parts_in;
    __device__ __forceinline__ void operator()(const f32x4 (&acc)[2][2][4][2], const Unit& u, int wr, int wc, int fr, int fq) const {
        int lv = threadIdx.x & 63; if constexpr (!XF32) { asm volatile("" : "+v"(lv)); fr = lv & 15; fq = lv >> 4; }
        const int a16 = (lv ^ 16) << 2, a32 = (lv ^ 32) << 2;
        const int row0 = u.pm * BM + wr * 64 + fr, col0 = u.pn * BM + wc * 32 + 8 * fq;
        if constexpr (!XF32) {
            u32x4 xw[2][4][2];
#pragma unroll
            for (int ai = 0; ai < 2; ++ai)
#pragma unroll
                for (int m = 0; m < 4; ++m)
#pragma unroll
                    for (int bj = 0; bj < 2; ++bj) xw[ai][m][bj] = *(const u32x4*)(xb + (size_t)(row0 + ai * HALF + m * 16) * 1024 + col0 + bj * HALF);
            asm volatile("" ::: "memory");
            float rs[2][4];
#pragma unroll
            for (int ai = 0; ai < 2; ++ai) {
#pragma unroll
                for (int m = 0; m < 4; ++m) rs[ai][m] = NP ? row_rs_a<(NP ? NP : 16)>(parts_in, row0 + ai * HALF + m * 16, fq, a16, a32) : 1.0f;
                asm volatile("" ::: "memory"); }
#pragma unroll
            for (int ai = 0; ai < 2; ++ai)
#pragma unroll
                for (int m = 0; m < 4; ++m) { const int row = row0 + ai * HALF + m * 16; const size_t off = (size_t)row * 1024 + col0; const float s = rs[ai][m]; float ss = 0.f;
#pragma unroll
                    for (int bj = 0; bj < 2; ++bj) { const u32x4 w0 = xw[ai][m][bj];
                        const f32x4 x0 = (f32x4){__builtin_bit_cast(float, w0.x << 16), __builtin_bit_cast(float, w0.x & 0xffff0000u), __builtin_bit_cast(float, w0.y << 16), __builtin_bit_cast(float, w0.y & 0xffff0000u)};
                        const f32x4 x1 = (f32x4){__builtin_bit_cast(float, w0.z << 16), __builtin_bit_cast(float, w0.z & 0xffff0000u), __builtin_bit_cast(float, w0.w << 16), __builtin_bit_cast(float, w0.w & 0xffff0000u)};
                        const f32x4 y0 = x0 + acc[ai][bj][m][0] * s, y1 = x1 + acc[ai][bj][m][1] * s;
                        *(u32x4*)(xb + off + bj * HALF) = pack8(y0, y1);
                        ss += ((y0[0] * y0[0] + y0[1] * y0[1]) + (y0[2] * y0[2] + y0[3] * y0[3])) + ((y1[0] * y1[0] + y1[1] * y1[1]) + (y1[2] * y1[2] + y1[3] * y1[3])); }
                    ss += bperm(a16, ss); ss += bperm(a32, ss);
                    if (fq == 0) rowss_out[(size_t)row * 16 + u.pn * 4 + wc] = ss; }
        } else {
        float rs[2][4];
#pragma unroll
        for (int ai = 0; ai < 2; ++ai)
#pragma unroll
            for (int m = 0; m < 4; ++m) rs[ai][m] = NP ? row_rs<(NP ? NP : 16)>(parts_in, row0 + ai * HALF + m * 16, fq) : 1.0f;
#pragma unroll
        for (int ai = 0; ai < 2; ++ai)
#pragma unroll
            for (int m = 0; m < 4; ++m) { const int row = row0 + ai * HALF + m * 16; const size_t off = (size_t)row * 1024 + col0; const float s = rs[ai][m]; float ss = 0.f;
#pragma unroll
                for (int bj = 0; bj < 2; ++bj) { const size_t o2 = off + bj * HALF;
                    const f32x4 x0 = *(const f32x4*)(xin + o2), x1 = *(const f32x4*)(xin + o2 + 4);
                    const f32x4 y0 = x0 + acc[ai][bj][m][0] * s, y1 = x1 + acc[ai][bj][m][1] * s;
                    *(u32x4*)(xb + o2) = pack8(y0, y1);
                    ss += ((y0[0] * y0[0] + y0[1] * y0[1]) + (y0[2] * y0[2] + y0[3] * y0[3])) + ((y1[0] * y1[0] + y1[1] * y1[1]) + (y1[2] * y1[2] + y1[3] * y1[3])); }
                ss += __shfl_xor(ss, 16); ss += __shfl_xor(ss, 32);
                if (fq == 0) rowss_out[(size_t)row * 16 + u.pn * 4 + wc] = ss;
                if (m == 3) asm volatile("" ::: "memory"); }
        }
    }
};
}

constexpr int NWAVES = 8;
constexpr int BATCH = 16, SEQ = 4096, D = 1024, M = BATCH * SEQ;
constexpr int GLA_H = 4, GLA_DK = 128, GLA_DV = 256, GLA_KEY = 512, GLA_IN = 3088, GLA_N = 3584;
constexpr int HG_H = 8, HG_N = 4096;
constexpr int FF = 2816, FF2 = 2 * FF;
constexpr float NORM_EPS = 1e-6f;
#ifndef MK_PER_PHASE
#define MK_PER_PHASE 0
#endif
constexpr int N_PHASES = 14;

constexpr size_t MiB = 1u << 20;
constexpr size_t WS_CTL = 0, CTL_ZERO_BYTES = 64 * 1024;
constexpr size_t WS_W_GLA = 2 * MiB;
constexpr size_t WS_W_O0 = 9 * MiB;
constexpr size_t WS_W_F0I = 11 * MiB;
constexpr size_t WS_W_F0O = 22 * MiB;
constexpr size_t WS_W_HG = 28 * MiB;
constexpr size_t WS_W_O1 = 36 * MiB;
constexpr size_t WS_W_F1I = 38 * MiB;
constexpr size_t WS_W_F1O = 49 * MiB;
constexpr size_t WS_ROWSS = 56 * MiB;
constexpr size_t WS_SSQH = 60 * MiB;
constexpr size_t WS_LBT = 62 * MiB;
constexpr size_t WS_XB = 64 * MiB;
constexpr size_t WS_YB = 192 * MiB;
constexpr size_t WS_P0 = 320 * MiB;
constexpr size_t WS_HB = 320 * MiB;
constexpr size_t WS_SEGL = 832 * MiB;
constexpr size_t WS_SEGB = 856 * MiB;
constexpr size_t WS_END = 857 * MiB;

constexpr int RING_OFF = 0, RING_BYTES = 131072;
constexpr int LDSCTL_OFF = RING_BYTES, MISC_OFF = LDSCTL_OFF + 320;
constexpr int LDS_BYTES = 147456;
static_assert(MISC_OFF + 128 <= LDS_BYTES, "LDS map");

#define GAS __attribute__((address_space(1)))
#define LAS __attribute__((address_space(3)))
typedef unsigned short bf16;
typedef unsigned v4u __attribute__((ext_vector_type(4)));
typedef unsigned v2u __attribute__((ext_vector_type(2)));
typedef float f32x4 __attribute__((ext_vector_type(4)));
typedef short bf16x8 __attribute__((ext_vector_type(8)));
typedef GAS unsigned gu32;
#define RLX_AGENT __ATOMIC_RELAXED, __HIP_MEMORY_SCOPE_AGENT
#define LDS_WAIT() asm volatile("s_waitcnt lgkmcnt(0)" ::: "memory")
#define VM_WAIT() asm volatile("s_waitcnt vmcnt(0)" ::: "memory")
__device__ __forceinline__ unsigned f2bf(float f) { unsigned u = __builtin_bit_cast(unsigned, f); return (u + 0x7fffu + ((u >> 16) & 1u)) >> 16; }
__device__ __forceinline__ unsigned pk2(float lo, float hi) { return f2bf(lo) | (f2bf(hi) << 16); }
__device__ __forceinline__ float bf2f(bf16 b) { return __builtin_bit_cast(float, (unsigned)b << 16); }
#define XB_TMO      128
#define XB_XCNT(j)  (256  + 64 * (j))
#define XB_XSUB(j)  (1280 + 64 * (j))
#define XB_XGEN(j)  (2304 + 64 * (j))
#define XB_TOP      3328
#define XB_TOPGEN   3392
#define XCD_BAR_WORDS 3456
#define XB_SPIN_CAP (1u << 18)

__device__ __forceinline__ unsigned xb_ld(unsigned* p)              { return __hip_atomic_load(p, __ATOMIC_RELAXED, __HIP_MEMORY_SCOPE_AGENT); }
__device__ __forceinline__ unsigned xb_add(unsigned* p, unsigned v) { return __hip_atomic_fetch_add(p, v, __ATOMIC_RELAXED, __HIP_MEMORY_SCOPE_AGENT); }
__device__ __forceinline__ unsigned xb_xcc_id() { return (unsigned)__builtin_amdgcn_s_getreg((3 << 11) | 20) & 0xFu; }
#define XB_SPIN(cond, bar) do { unsigned _sp = 0; while (cond) { __builtin_amdgcn_s_sleep(1); \
    if ((++_sp & 255u) == 0u) { if (xb_ld(&(bar)[XB_TMO])) break; if (_sp > XB_SPIN_CAP) { atomicAdd(&(bar)[XB_TMO], 1u); break; } } } } while (0)

struct XcdBarrier {
    unsigned* bar; unsigned x;
    volatile LAS unsigned* st;
};

__device__ __forceinline__ XcdBarrier xcd_barrier_post(unsigned* bar, volatile LAS unsigned* st) {
    XcdBarrier b; b.bar = bar; b.x = xb_xcc_id(); b.st = st;
    if (threadIdx.x == 0) (void)xb_add(&bar[XB_XCNT(b.x)], 1u);
    return b;
}
__device__ __forceinline__ void xcd_barrier_complete(unsigned* bar, unsigned x, unsigned& nloc, unsigned& nx) {
    const unsigned G = gridDim.x * gridDim.y * gridDim.z;
    unsigned sum, cnt, mine, sp = 0u;
    for (;;) {
        sum = 0u; cnt = 0u; mine = 0u;
#pragma unroll
        for (unsigned j = 0; j < 16; ++j) { const unsigned c = xb_ld(&bar[XB_XCNT(j)]); sum += c; cnt += (c > 0u) ? 1u : 0u; mine = (j == x) ? c : mine; }
        if (sum == G) break;
        __builtin_amdgcn_s_sleep(1);
        if ((++sp & 255u) == 0u) { if (xb_ld(&bar[XB_TMO])) break; if (sp > XB_SPIN_CAP) { atomicAdd(&bar[XB_TMO], 1u); break; } }
    }
    nloc = mine > 0u ? mine : 1u; nx = cnt > 0u ? cnt : 1u;
}

__device__ __forceinline__ void xcd_barrier(const XcdBarrier& b) {
    asm volatile("s_waitcnt vmcnt(0)" ::: "memory");
    __syncthreads();
    if (threadIdx.x == 0) {
        unsigned* bar = b.bar;
        __builtin_amdgcn_s_waitcnt(0);
        unsigned nloc = b.st[0], nx = b.st[1];
        if (nloc == 0u) { xcd_barrier_complete(bar, b.x, nloc, nx); b.st[0] = nloc; b.st[1] = nx; }
        const unsigned old = xb_add(&bar[XB_XSUB(b.x)], 1u);
        const unsigned gen = old / nloc;
        if (old + 1u == (gen + 1u) * nloc) {
            __builtin_amdgcn_fence(__ATOMIC_RELEASE, "agent");
            asm volatile("s_waitcnt vmcnt(0)" ::: "memory");
            const unsigned og = xb_add(&bar[XB_TOP], 1u);
            const unsigned tg = og / nx;
            if (og + 1u == (tg + 1u) * nx) xb_add(&bar[XB_TOPGEN], 1u);
            else XB_SPIN(xb_ld(&bar[XB_TOPGEN]) == tg, bar);
            __builtin_amdgcn_fence(__ATOMIC_ACQUIRE, "agent");
            xb_add(&bar[XB_XGEN(b.x)], 1u);
            asm volatile("s_waitcnt vmcnt(0)" ::: "memory");
        } else {
            XB_SPIN(xb_ld(&bar[XB_XGEN(b.x)]) == gen, bar);
            __builtin_amdgcn_fence(__ATOMIC_ACQUIRE, "agent");
            asm volatile("s_waitcnt vmcnt(0)" ::: "memory");
        }
    }
    __syncthreads();
}

__device__ __forceinline__ float wave_sum(float v) {
#pragma unroll
    for (int o = 1; o < 64; o <<= 1) v += __shfl_xor(v, o);
    return v;
}
__device__ __forceinline__ void p0_gain_load(const float* gain, int k0, int lane, f32x4 (&g)[2]) {
    g[0] = (f32x4){1.f, 1.f, 1.f, 1.f}; g[1] = g[0];
    if (gain) { g[0] = *(const f32x4*)(gain + k0 + 8 * (lane & 7)); g[1] = *(const f32x4*)(gain + k0 + 8 * (lane & 7) + 4); }
}
__device__ __forceinline__ void p0_tile_out(bf16* WT, int Kp, int drow0, int k0, LAS float* scr, int lane, const f32x4 (&g)[2]) {
    const int c = lane & 7;
    LDS_WAIT(); asm volatile("" ::: "memory");
#pragma unroll
    for (int j = 0; j < 4; ++j) { const int n = (lane >> 3) + 8 * j; const LAS float* s = scr + (8 * c) * 33 + n;
        v4u o; o.x = pk2(s[0 * 33] * g[0].x, s[1 * 33] * g[0].y); o.y = pk2(s[2 * 33] * g[0].z, s[3 * 33] * g[0].w); o.z = pk2(s[4 * 33] * g[1].x, s[5 * 33] * g[1].y); o.w = pk2(s[6 * 33] * g[1].z, s[7 * 33] * g[1].w);
        *(GAS v4u*)(WT + (size_t)(drow0 + n) * Kp + k0 + 8 * c) = o; }
    LDS_WAIT(); asm volatile("" ::: "memory");
}
struct P0Item { const float* W; const float* gain; bf16* WT; int ldw, k0, n0, Kp, drow0; };
__device__ __forceinline__ void p0_item_load(const P0Item& t, f32x4 (&w)[8], f32x4 (&g)[2], int lane) {
    const int kr = lane >> 3, nq = lane & 7;
    p0_gain_load(t.gain, t.k0, lane, g);
#pragma unroll
    for (int i = 0; i < 8; ++i) w[i] = *(const f32x4*)(t.W + (size_t)(t.k0 + 8 * i + kr) * t.ldw + t.n0 + 4 * nq);
}
__device__ __forceinline__ void p0_item_finish(const P0Item& t, const f32x4 (&w)[8], const f32x4 (&g)[2], LAS float* scr, int lane) {
    const int kr = lane >> 3, nq = lane & 7;
#pragma unroll
    for (int i = 0; i < 8; ++i) { LAS float* d = scr + (8 * i + kr) * 33 + 4 * nq; d[0] = w[i].x; d[1] = w[i].y; d[2] = w[i].z; d[3] = w[i].w; }
    p0_tile_out(t.WT, t.Kp, t.drow0, t.k0, scr, lane, g);
}
__device__ __forceinline__ void p0_w12_item(const float* Win, const float* Wgu, int k0, int n0, const float* gain, bf16* WT, int drow0, LAS float* scr, int lane) {
    LAS float* w1s = scr + 2304;
    { const f32x4* src = (const f32x4*)(Win + (size_t)(k0 + lane) * GLA_IN + 3072); const f32x4 a0 = src[0], a1 = src[1], a2 = src[2], a3 = src[3];
      LAS f32x4* d = (LAS f32x4*)(w1s + lane * 20); d[0] = a0; d[1] = a1; d[2] = a2; d[3] = a3; }
    float w2[16]; f32x4 g[2]; p0_gain_load(gain, k0, lane, g);
#pragma unroll
    for (int r = 0; r < 16; ++r) w2[r] = Wgu[r * GLA_KEY + n0 + (lane & 31)];
    LDS_WAIT(); asm volatile("" ::: "memory");
#pragma unroll 4
    for (int i = 0; i < 32; ++i) { const int kk = 2 * i + (lane >> 5); const LAS f32x4* w1 = (const LAS f32x4*)(w1s + kk * 20); float s = 0.f;
#pragma unroll
        for (int q = 0; q < 4; ++q) { const f32x4 t = w1[q]; s += (t.x * w2[4 * q] + t.y * w2[4 * q + 1]) + (t.z * w2[4 * q + 2] + t.w * w2[4 * q + 3]); }
        scr[kk * 33 + (lane & 31)] = s; }
    p0_tile_out(WT, D, drow0, k0, scr, lane, g);
}
#define P0_ROWS_LOAD(v, mm) do { _Pragma("unroll") for (int r_ = 0; r_ < 4; ++r_) { const GAS f32x4* xr_ = (const GAS f32x4*)(x + (size_t)((mm) + r_ * rstride) * D) + lane; \
        _Pragma("unroll") for (int j_ = 0; j_ < 4; ++j_) v[r_][j_] = xr_[64 * j_]; } } while (0)
#define P0_ROWS_STORE(v, mm) do { float s_[4]; \
        _Pragma("unroll") for (int r_ = 0; r_ < 4; ++r_) { float t_ = 0.f; \
            _Pragma("unroll") for (int j_ = 0; j_ < 4; ++j_) t_ += (v[r_][j_].x * v[r_][j_].x + v[r_][j_].y * v[r_][j_].y) + (v[r_][j_].z * v[r_][j_].z + v[r_][j_].w * v[r_][j_].w); \
            s_[r_] = wave_sum(t_); } \
        _Pragma("unroll") for (int r_ = 0; r_ < 4; ++r_) { GAS v4u* o_ = (GAS v4u*)(xb + (size_t)((mm) + r_ * rstride) * D) + (lane >> 1) + 32 * (lane & 1); \
            _Pragma("unroll") for (int i_ = 0; i_ < 2; ++i_) { \
                const unsigned a0_ = pk2(v[r_][2 * i_].x, v[r_][2 * i_].y), a1_ = pk2(v[r_][2 * i_].z, v[r_][2 * i_].w), b0_ = pk2(v[r_][2 * i_ + 1].x, v[r_][2 * i_ + 1].y), b1_ = pk2(v[r_][2 * i_ + 1].z, v[r_][2 * i_ + 1].w); \
                const unsigned t0_ = odd_ ? a0_ : b0_, t1_ = odd_ ? a1_ : b1_;                                     \
                const unsigned q0_ = (unsigned)__builtin_amdgcn_mov_dpp((int)t0_, 0xB1, 0xF, 0xF, true), q1_ = (unsigned)__builtin_amdgcn_mov_dpp((int)t1_, 0xB1, 0xF, 0xF, true); \
                v4u w_; if (odd_) { w_.x = q0_; w_.y = q1_; w_.z = b0_; w_.w = b1_; } else { w_.x = a0_; w_.y = a1_; w_.z = q0_; w_.w = q1_; } \
                o_[64 * i_] = w_; } \
            if (lane < 16) rowss[(size_t)((mm) + r_ * rstride) * 16 + lane] = (lane == 0) ? s_[r_] : 0.f; } } while (0)
__device__ __forceinline__ void p0_rows(const float* x, bf16* xb, float* rowss, int m0, int mstep, int rstride, int lane) {
    f32x4 va[4][4], vb[4][4]; const bool odd_ = lane & 1;
    P0_ROWS_LOAD(va, m0);
    for (int m = m0; m < M; m += 2 * mstep) {
        P0_ROWS_LOAD(vb, m + mstep); asm volatile("" ::: "memory");
        P0_ROWS_STORE(va, m); asm volatile("" ::: "memory");
        if (m + 2 * mstep < M) P0_ROWS_LOAD(va, m + 2 * mstep);
        asm volatile("" ::: "memory");
        P0_ROWS_STORE(vb, m + mstep); asm volatile("" ::: "memory");
    }
}
#undef P0_ROWS_LOAD
#undef P0_ROWS_STORE

struct Ptrs {
    const float *x, *mixer_norm, *ffn_norm, *gla_w_in, *gla_w_gu, *gla_b_gate, *gla_head_norm, *gla_w_out, *hg_w_in, *hg_lb, *hg_out_norm, *hg_w_out, *ffn_w_in, *ffn_w_out, *final_norm;
    float* out;
    bf16 *Wgla, *Wo0, *Wf0i, *Wf0o, *Whg, *Wo1, *Wf1i, *Wf1o;
    float *rowss, *ssqh, *segL, *segB, *lbt;
    bf16 *XB, *YB, *HB;
    bf16 *gQ, *gK, *gV, *gR, *gZ;
    bf16 *hQ, *hF, *hV, *hG;
};

__device__ __forceinline__ void p0_prologue(const Ptrs& P, LAS unsigned char* lds, int wave, int lane, int G) {
    LAS float* scr = (LAS float*)(lds + RING_OFF + wave * 16384);
    const int gw = blockIdx.x * NWAVES + wave, NGW = G * NWAVES;
    constexpr int KB1 = D / 64, KB2 = FF / 64;
    constexpr int I_GLA = KB1 * (3072 / 32), I_W12 = KB1 * (GLA_KEY / 32), I_O = KB1 * (D / 32), I_FI = KB1 * (FF2 / 32), I_FO = KB2 * (D / 32), I_HG = KB1 * (HG_N / 32);
    constexpr int NT = I_GLA + 2 * I_O + 2 * I_FI + 2 * I_FO + I_HG;
    for (int it = gw; it < I_W12; it += NGW) { const int nb = it % 16, kb = it / 16; p0_w12_item(P.gla_w_in, P.gla_w_gu, 64 * kb, 32 * nb, P.mixer_norm, P.Wgla, 3072 + 32 * nb, scr, lane); }
    auto decode = [&](int r, P0Item& t) {
        if (r < I_GLA) { const int nb = r % 96, kb = r / 96; t = P0Item{P.gla_w_in, P.mixer_norm, P.Wgla, GLA_IN, 64 * kb, 32 * nb, D, 32 * nb}; return; } r -= I_GLA;
        if (r < I_O) { const int nb = r % 32, kb = r / 32; t = P0Item{P.gla_w_out, nullptr, P.Wo0, D, 64 * kb, 32 * nb, D, 32 * nb}; return; } r -= I_O;
        if (r < I_O) { const int nb = r % 32, kb = r / 32; t = P0Item{P.hg_w_out, P.hg_out_norm, P.Wo1, D, 64 * kb, 32 * nb, D, 32 * nb}; return; } r -= I_O;
        if (r < 2 * I_FI) { const int l = r / I_FI; r -= l * I_FI; const int nb = r % 176, kb = r / 176, n0 = 32 * nb, bj = n0 / FF, c = n0 % FF;
            t = P0Item{P.ffn_w_in + (size_t)l * D * FF2, P.ffn_norm + l * D, l ? P.Wf1i : P.Wf0i, FF2, 64 * kb, n0, D, 256 * (c / 128) + 128 * bj + (c % 128)}; return; } r -= 2 * I_FI;
        if (r < 2 * I_FO) { const int l = r / I_FO; r -= l * I_FO; const int nb = r % 32, kb = r / 32;
            t = P0Item{P.ffn_w_out + (size_t)l * FF * D, nullptr, l ? P.Wf1o : P.Wf0o, D, 64 * kb, 32 * nb, FF, 32 * nb}; return; } r -= 2 * I_FO;
        { const int nb = r % 128, kb = r / 128; t = P0Item{P.hg_w_in, P.mixer_norm + D, P.Whg, HG_N, 64 * kb, 32 * nb, D, 32 * nb}; }
    };
    if (gw < NT) {
        P0Item cur, nxt; f32x4 wc[8], wn[8], gc[2], gn[2];
        int it = gw; decode(it, cur); p0_item_load(cur, wc, gc, lane);
        for (;;) {
            const int nit = it + NGW; const bool more = nit < NT;
            if (more) { decode(nit, nxt); p0_item_load(nxt, wn, gn, lane); }
            asm volatile("" ::: "memory");
            p0_item_finish(cur, wc, gc, scr, lane);
            if (!more) break;
#pragma unroll
            for (int i = 0; i < 8; ++i) wc[i] = wn[i];
            gc[0] = gn[0]; gc[1] = gn[1]; cur = nxt; it = nit;
        }
    }
    if (gw < 16) { const int c = gw * 64 + lane; const float l0 = P.hg_lb[c], l1 = P.hg_lb[D + c], mx = fmaxf(l0, l1), e0 = __expf(l0 - mx), e1 = __expf(l1 - mx); P.lbt[c] = e1 / (e0 + e1); }
    p0_rows(P.x, P.XB, P.rowss, gw, 4 * NGW, NGW, lane);
}

__device__ __forceinline__ void final_norm_rows(const Ptrs& P, int wave, int lane, int G) {
    const int gw = blockIdx.x * NWAVES + wave, NGW = G * NWAVES, mstep = 4 * NGW;
    f32x4 g[4];
#pragma unroll
    for (int j = 0; j < 4; ++j) g[j] = ((const f32x4*)P.final_norm)[lane + 64 * j];
#define FN_LOAD(WQ, SPQ, mm) do { _Pragma("unroll") for (int r_ = 0; r_ < 4; ++r_) { const size_t mr_ = (size_t)((mm) + r_ * NGW); SPQ[r_] = P.rowss[mr_ * 16 + (lane & 15)]; const v2u* xr_ = (const v2u*)(P.XB + mr_ * D) + lane; \
        _Pragma("unroll") for (int j_ = 0; j_ < 4; ++j_) WQ[r_][j_] = xr_[64 * j_]; } } while (0)
#define FN_STORE(WQ, SPQ, mm) do { _Pragma("unroll") for (int r_ = 0; r_ < 4; ++r_) { float s_ = SPQ[r_]; s_ += __shfl_xor(s_, 1); s_ += __shfl_xor(s_, 2); s_ += __shfl_xor(s_, 4); s_ += __shfl_xor(s_, 8); \
        const float rs_ = 1.0f / sqrtf(s_ * (1.0f / 1024.0f) + NORM_EPS); f32x4* orow_ = (f32x4*)(P.out + (size_t)((mm) + r_ * NGW) * D) + lane; \
        _Pragma("unroll") for (int j_ = 0; j_ < 4; ++j_) { const v2u q_ = WQ[r_][j_]; \
            const f32x4 v_ = {bf2f((bf16)(q_.x & 0xffffu)), bf2f((bf16)(q_.x >> 16)), bf2f((bf16)(q_.y & 0xffffu)), bf2f((bf16)(q_.y >> 16))}; orow_[64 * j_] = v_ * rs_ * g[j_]; } } } while (0)
    v2u wa[4][4], wb[4][4]; float spa[4], spb[4];
    FN_LOAD(wa, spa, gw);
    for (int m = gw; m < M; m += 2 * mstep) {
        FN_LOAD(wb, spb, m + mstep); asm volatile("" ::: "memory");
        FN_STORE(wa, spa, m); asm volatile("" ::: "memory");
        if (m + 2 * mstep < M) FN_LOAD(wa, spa, m + 2 * mstep);
        asm volatile("" ::: "memory");
        FN_STORE(wb, spb, m + mstep); asm volatile("" ::: "memory");
    }
#undef FN_LOAD
#undef FN_STORE
}

namespace cs {
typedef short s16x4 __attribute__((ext_vector_type(4)));
typedef float f32x16 __attribute__((ext_vector_type(16)));
typedef __bf16 bf16v2 __attribute__((ext_vector_type(2)));
constexpr int A2_OFF = 0, O_OFF = 0, K2_OFF = 34816, V_OFF = 67584, P_OFF = 100352, PSZ = 9216, TOT_OFF = 118784, CV_OFF = 126976, GAIN_OFF = 130048;
constexpr float LOG2E = 1.44269504089f;
constexpr int NSEG = 4, SEG_CH = SEQ / 64 / NSEG;
__device__ __forceinline__ unsigned off_b(unsigned row, unsigned ch) { return 2048u * (row >> 3) + 512u * (ch >> 2) + 64u * (row & 7u) + 16u * ((ch & 3u) ^ ((row >> 2) & 3u)); }
__device__ __forceinline__ unsigned off_p(unsigned i, unsigned ch) { return 144u * i + 16u * ch; }
__device__ __forceinline__ unsigned off_o(unsigned i, unsigned ch) { return 528u * i + 16u * ch; }
__device__ __forceinline__ unsigned tr_addr(unsigned lane, unsigned c, unsigned ks, unsigned t) {
    const unsigned h = lane >> 5, blk = (lane >> 4) & 1u, q = (lane & 15u) >> 2, p = lane & 3u;
    return off_b(16u * ks + 8u * h + 4u * t + q, 4u * c + 2u * blk + (p >> 1)) + 8u * (p & 1u);
}
__device__ __forceinline__ s16x4 tr_read(LAS unsigned char* p) { return __builtin_amdgcn_ds_read_tr16_b64_v4i16((LAS s16x4*)p); }
__device__ __forceinline__ unsigned pkb(float a, float b) { bf16v2 v = {(__bf16)a, (__bf16)b}; return __builtin_bit_cast(unsigned, v); }
__device__ __forceinline__ float blo(unsigned u) { return __builtin_bit_cast(float, u << 16); }
__device__ __forceinline__ float bhi(unsigned u) { return __builtin_bit_cast(float, u & 0xffff0000u); }
__device__ __forceinline__ bf16x8 cat8(s16x4 lo, s16x4 hi) { return __builtin_shufflevector(lo, hi, 0, 1, 2, 3, 4, 5, 6, 7); }
__device__ __forceinline__ void wave_pair(const f32x4& tot, f32x4& lo, f32x4& wt) {
#pragma unroll
    for (int e = 0; e < 4; ++e) { float a = tot[e], b = tot[e];
        asm("v_permlane32_swap_b32 %0, %1" : "+v"(a), "+v"(b));
        lo[e] = a; wt[e] = a + b; }
}
#define CS_MFMA32(a, b, c) __builtin_amdgcn_mfma_f32_32x32x16_bf16((a), (b), (c), 0, 0, 0)
#define CS_MFMA16(a, b, c) __builtin_amdgcn_mfma_f32_16x16x32_bf16((a), (b), (c), 0, 0, 0)

template <bool HG>
__device__ __forceinline__ void scan_chunk_unit(const Ptrs& P, LAS unsigned char* lds, const int tid, const int u, const int seg) {
    constexpr int SETS = HG ? 2 : 1, TPS = 512 / SETS, TG = TPS / 32, NT = 64 / TG;
    constexpr int PQ = HG ? 1024 : 512, NCH = SEG_CH;
    const int lane = tid & 63, wave = __builtin_amdgcn_readfirstlane(tid >> 6);
    const int b = u >> 2, hq = u & 3;
    const int set = HG ? (wave >> 2) : 0, wset = HG ? (wave & 3) : wave;
    const int ts = tid & (TPS - 1), dq = ts & 31, tg = ts >> 5;
    const int qkcol = (HG ? (2 * hq + set) : hq) * 128 + 4 * dq, vcol0 = hq * 256;
    const int dqs = (dq & ~3) | (((dq & 3) == 1) ? 2 : ((dq & 3) == 2) ? 1 : (dq & 3));
    const int r = lane & 31, h = lane >> 5, vhalf = wave >> 2, vc = wave & 3;
    const int orow = tid >> 3, ocg = tid & 7;
    const size_t row0 = (size_t)b * SEQ + (size_t)seg * (SEG_CH * 64);
    const char* Qn = (const char*)((HG ? P.hQ : P.gQ) + row0 * PQ); const char* Kn = (const char*)((HG ? P.hF : P.gK) + row0 * PQ); const char* Zn = (const char*)(P.gZ + row0 * PQ);
    const char* Vn = (const char*)((HG ? P.hV : P.gV) + row0 * 1024); const char* Gn = (const char*)((HG ? P.hG : P.gR) + row0 * 1024); char* Yn = (char*)(P.YB + row0 * 1024);
    float* SSn = P.ssqh + row0 * 8;
    const unsigned A2s = A2_OFF + set * 16384, K2s = K2_OFF + set * 16384;
#define CS_BASES_PREP(tv) const int lane_ = (tv) & 63, ts_ = (tv) & (TPS - 1), dq_ = ts_ & 31, tg_ = ts_ >> 5, orow_ = (tv) >> 3, ocg_ = (tv) & 7; \
    const int dqs_ = (dq_ & ~3) | (((dq_ & 3) == 1) ? 2 : ((dq_ & 3) == 2) ? 1 : (dq_ & 3)); \
    const unsigned vqk = (unsigned)((tg_ * NT) * PQ + (HG ? (2 * hq + set) : hq) * 128 + 4 * dq_) * 2u, vrow = (unsigned)(orow_ * 1024 + vcol0 + 32 * ocg_) * 2u, vrowV = (unsigned)(orow_ * 1024 + vcol0 + 8 * ocg_) * 2u; \
    const unsigned wA2 = A2s + off_b(tg_ * NT, dq_ >> 1) + 8 * (dq_ & 1), wK2 = K2s + off_b(tg_ * NT, dqs_ >> 1) + 8 * (dqs_ & 1); \
    const unsigned wA2b = A2s + off_b(tg_ * NT + 4, dq_ >> 1) + 8 * (dq_ & 1), wK2b = K2s + off_b(tg_ * NT + 4, dqs_ >> 1) + 8 * (dqs_ & 1); \
    const unsigned TOTw = TOT_OFF + (set * (TG * 64) + wset * 128 + 4 * dq_) * 4, TOTr = TOT_OFF + (set * (TG * 64) + 4 * dq_) * 4, CVw = CV_OFF + (set * 384 + 4 * dqs_) * 4; \
    const unsigned xV = (orow_ >> 2) & 3, wV = V_OFF + 2048 * (orow_ >> 3) + 64 * (orow_ & 7) + 512 * (ocg_ >> 2) + 16 * ((ocg_ & 3) ^ xV);     (void)lane_; (void)wA2b; (void)wK2b
#define CS_BASES_MMA(tv) const int lm_ = (tv) & 63, r_ = lm_ & 31, h_ = lm_ >> 5; \
    const unsigned CVr = CV_OFF + (set * 384 + 4 * h_) * 4; \
    const unsigned rA2[2] = {A2s + off_b(r_, h_), A2s + off_b(r_, 2 + h_)}; \
    const unsigned rV[2] = {V_OFF + vhalf * 16384 + tr_addr(lm_, vc, 0, 0), V_OFF + vhalf * 16384 + tr_addr(lm_, vc, 0, 1)}; \
    const unsigned rK[2] = {K2s + tr_addr(lm_, 0, 0, 0), K2s + tr_addr(lm_, 0, 0, 1)}; \
    const unsigned rP = P_OFF + set * PSZ + 144 * r_ + 16 * h_, wO = O_OFF + 528 * r_ + 64 * wave + 8 * h_; \
    const int ic = lm_ & 15, g = lm_ >> 4; \
    const unsigned tK = off_b(ic, g), tA0 = off_b(ic, 2 * (g >> 1)) + 8 * (g & 1), tA1 = off_b(ic, 2 * (g >> 1) + 1) + 8 * (g & 1), tP = 144 * ic + 16 * (g >> 1) + 8 * (g & 1)
#define CS_BASES_OUT(tv) const int orow_ = (tv) >> 3, ocg_ = (tv) & 7; const unsigned vrowV = (unsigned)(orow_ * 1024 + vcol0 + 8 * ocg_) * 2u, rO = O_OFF + 528 * orow_ + 16 * ocg_
    if (!HG) { if (tid < 256) ((LAS float*)(lds + GAIN_OFF))[tid] = P.gla_head_norm[tid]; }
    f32x16 S[4];
#pragma unroll
    for (int dt = 0; dt < 4; ++dt)
#pragma unroll
        for (int i = 0; i < 16; ++i) S[dt][i] = 0.f;
    for (int sp = 0; sp < seg; ++sp) {
        const float* Lp = P.segL + ((size_t)(u * (NSEG - 1) + sp) * 8 + wave) * 4096 + lane;
        const float* Bp = P.segB + (size_t)((u * (NSEG - 1) + sp) * 2 + set) * 128 + 4 * h;
#pragma unroll
        for (int dt = 0; dt < 4; ++dt)
#pragma unroll
            for (int g4 = 0; g4 < 4; ++g4) { const f32x4 bt = *(const f32x4*)(Bp + 32 * dt + 8 * g4);
#pragma unroll
                for (int e = 0; e < 4; ++e) S[dt][4 * g4 + e] = __builtin_amdgcn_exp2f(bt[e]) * S[dt][4 * g4 + e] + Lp[(dt * 16 + 4 * g4 + e) * 64]; }
    }
    v2u pq[NT], pk[NT], pz[NT]; v4u pv[4], pg[4];
#define CS_LOAD_QK() do { _Pragma("unroll") for (int i_ = 0; i_ < NT; ++i_) { pq[i_] = *(const v2u*)(Qn + i_ * PQ * 2 + vqk); pk[i_] = *(const v2u*)(Kn + i_ * PQ * 2 + vqk); if (!HG) pz[i_] = *(const v2u*)(Zn + i_ * PQ * 2 + vqk); } } while (0)
#define CS_LOAD_V() do { _Pragma("unroll") for (int c_ = 0; c_ < 4; ++c_) pv[c_] = *(const v4u*)(Vn + vrowV + 128 * c_); } while (0)
#define CS_LOAD_G() do { _Pragma("unroll") for (int c_ = 0; c_ < 4; ++c_) pg[c_] = *(const v4u*)(Gn + vrowV + 128 * c_); } while (0)
    { int tv0 = tid; asm volatile("" : "+v"(tv0)); CS_BASES_PREP(tv0); (void)wA2; (void)wK2; (void)TOTw; (void)TOTr; (void)CVw; (void)wV; (void)xV; (void)vrow; CS_LOAD_QK(); CS_LOAD_V(); }
    f32x4 c2log = {0.f, 0.f, 0.f, 0.f};
    for (int n = 0; n < NCH; ++n) {
        int tv1 = tid; asm volatile("" : "+v"(tv1));
        CS_BASES_PREP(tv1);
        CS_LOAD_G();
        float p[NT][4];
#pragma unroll
        for (int i = 0; i < NT; ++i) {
            float lg[4];
            if (HG) { lg[0] = blo(pk[i].x); lg[1] = bhi(pk[i].x); lg[2] = blo(pk[i].y); lg[3] = bhi(pk[i].y);
                pk[i].x = pkb(1.0f - __builtin_amdgcn_exp2f(lg[0]), 1.0f - __builtin_amdgcn_exp2f(lg[1])); pk[i].y = pkb(1.0f - __builtin_amdgcn_exp2f(lg[2]), 1.0f - __builtin_amdgcn_exp2f(lg[3])); }
            else { lg[0] = blo(pz[i].x); lg[1] = bhi(pz[i].x); lg[2] = blo(pz[i].y); lg[3] = bhi(pz[i].y); }
#pragma unroll
            for (int e = 0; e < 4; ++e) p[i][e] = (i ? p[i - 1][e] : 0.f) + lg[e];
        }
        f32x4 glo, gwt; wave_pair((f32x4){p[NT - 1][0], p[NT - 1][1], p[NT - 1][2], p[NT - 1][3]}, glo, gwt);
        *(LAS f32x4*)(lds + TOTw) = gwt;
        __syncthreads();
        {
            f32x4 before = (lane_ >= 32) ? glo : (f32x4){0.f, 0.f, 0.f, 0.f}, bmid = {0.f, 0.f, 0.f, 0.f}, blast = bmid;
#pragma unroll
            for (int gg = 0; gg < TG / 2; ++gg) { const f32x4 t = *(const LAS f32x4*)(lds + TOTr + gg * 512); blast += t; if (gg < TG / 4) bmid += t; if (gg < wset) before += t; }
#pragma unroll
            for (int i = 0; i < NT; ++i) {
                const float qv[4] = {blo(pq[i].x), bhi(pq[i].x), blo(pq[i].y), bhi(pq[i].y)}, kv[4] = {blo(pk[i].x), bhi(pk[i].x), blo(pk[i].y), bhi(pk[i].y)};
                float a2[4], k2[4];
#pragma unroll
                for (int e = 0; e < 4; ++e) { const float bb = before[e] + p[i][e] - bmid[e]; a2[e] = qv[e] * __builtin_amdgcn_exp2f(bb); k2[e] = kv[e] * __builtin_amdgcn_exp2f(-bb); }
                *(LAS v2u*)(lds + (i < 4 ? wA2 + 64 * i : wA2b + 64 * (i - 4))) = (v2u){pkb(a2[0], a2[1]), pkb(a2[2], a2[3])};
                *(LAS v2u*)(lds + (i < 4 ? wK2 + 64 * i : wK2b + 64 * (i - 4))) = (v2u){pkb(k2[0], k2[1]), pkb(k2[2], k2[3])}; asm volatile("" ::: "memory"); }
            if (tg_ == 0) { f32x4 cf;
#pragma unroll
                for (int e = 0; e < 4; ++e) cf[e] = __builtin_amdgcn_exp2f(c2log[e] + bmid[e]);
                *(LAS f32x4*)(lds + CVw) = cf; }
            c2log = blast - bmid;
#pragma unroll
            for (int c = 0; c < 4; ++c) *(LAS v4u*)(lds + wV + 16384 * (c >> 1) + 1024 * (c & 1)) = pv[c];
        }
        __syncthreads();
        Qn += 64 * PQ * 2; Kn += 64 * PQ * 2; Zn += 64 * PQ * 2; Vn += 64 * 2048;
        if (n + 1 < NCH) { CS_LOAD_QK(); CS_LOAD_V(); }
        int tv2 = tid; asm volatile("" : "+v"(tv2));
        CS_BASES_MMA(tv2);
        f32x16 o0, o1;
#pragma unroll
        for (int i = 0; i < 16; ++i) { o0[i] = 0.f; o1[i] = 0.f; }
#pragma unroll
        for (int dt = 0; dt < 4; ++dt)
#pragma unroll
            for (int s = 0; s < 2; ++s) {
                const f32x4 ca = *(const LAS f32x4*)(lds + CVr + (32 * dt + 16 * s) * 4), cb = *(const LAS f32x4*)(lds + CVr + (32 * dt + 16 * s + 8) * 4);
#pragma unroll
                for (int j = 0; j < 4; ++j) { S[dt][8 * s + j] *= ca[j]; S[dt][8 * s + 4 + j] *= cb[j]; }
                v4u sw; sw.x = pkb(S[dt][8 * s + 0], S[dt][8 * s + 1]); sw.y = pkb(S[dt][8 * s + 2], S[dt][8 * s + 3]);
                sw.z = pkb(S[dt][8 * s + 4], S[dt][8 * s + 5]); sw.w = pkb(S[dt][8 * s + 6], S[dt][8 * s + 7]);
                const bf16x8 sf = __builtin_bit_cast(bf16x8, sw);
                const bf16x8 a0 = *(const LAS bf16x8*)(lds + rA2[s] + 512 * dt), a1 = *(const LAS bf16x8*)(lds + rA2[s] + 512 * dt + 8192);
                o0 = CS_MFMA32(sf, a0, o0); o1 = CS_MFMA32(sf, a1, o1);
                asm volatile("" ::: "memory");
            }
        for (int task = wave; task < 12 * SETS; task += 8) {
            const int pset = HG ? (task >= 12 ? 1 : 0) : 0, tt = task - 12 * pset;
            int it, jt;
            if (tt < 10) { it = (tt >= 6) ? 3 : (tt >= 3) ? 2 : (tt >= 1) ? 1 : 0; jt = tt - (it * (it + 1)) / 2; } else { it = (tt == 10) ? 0 : 2; jt = it + 1; }
            const unsigned A2p = A2_OFF + pset * 16384 + 4096 * it, K2p = K2_OFF + pset * 16384 + 4096 * jt + tK, Pp = P_OFF + pset * PSZ + 144 * 16 * it + 32 * jt + tP;
            f32x4 acc = {0.f, 0.f, 0.f, 0.f};
            if (tt < 10) {
#pragma unroll
                for (int s = 0; s < 4; ++s) {
                    const bf16x8 ka = *(const LAS bf16x8*)(lds + K2p + 512 * s);
                    const s16x4 lo = *(const LAS s16x4*)(lds + A2p + tA0 + 512 * s), hi = *(const LAS s16x4*)(lds + A2p + tA1 + 512 * s);
                    acc = CS_MFMA16(ka, cat8(lo, hi), acc);
                }
                if (jt == it) {
#pragma unroll
                    for (int e = 0; e < 4; ++e) if (4 * g + e > ic) acc[e] = 0.f; }
            }
            *(LAS v2u*)(lds + Pp) = (v2u){pkb(acc[0], acc[1]), pkb(acc[2], acc[3])};
        }
        __syncthreads();
        bf16x8 vf[4];
#pragma unroll
        for (int ks = 0; ks < 4; ++ks) vf[ks] = cat8(tr_read(lds + rV[0] + 4096 * ks), tr_read(lds + rV[1] + 4096 * ks));
#pragma unroll
        for (int ks = 0; ks < 2; ++ks) o0 = CS_MFMA32(vf[ks], *(const LAS bf16x8*)(lds + rP + 32 * ks), o0);
#pragma unroll
        for (int ks = 0; ks < 4; ++ks) o1 = CS_MFMA32(vf[ks], *(const LAS bf16x8*)(lds + rP + 32 * ks + 4608), o1);
#pragma unroll
        for (int g4 = 0; g4 < 4; ++g4) {
            *(LAS v2u*)(lds + wO + 16 * g4) = (v2u){pkb(o0[4 * g4], o0[4 * g4 + 1]), pkb(o0[4 * g4 + 2], o0[4 * g4 + 3])};
            *(LAS v2u*)(lds + wO + 16 * g4 + 16896) = (v2u){pkb(o1[4 * g4], o1[4 * g4 + 1]), pkb(o1[4 * g4 + 2], o1[4 * g4 + 3])};
        }
asm volatile("" ::: "memory");
#pragma unroll
        for (int dt = 0; dt < 4; ++dt) {
#pragma unroll
            for (int ks = 0; ks < 4; ++ks) S[dt] = CS_MFMA32(cat8(tr_read(lds + rK[0] + 512 * dt + 4096 * ks), tr_read(lds + rK[1] + 512 * dt + 4096 * ks)), vf[ks], S[dt]);
            asm volatile("" ::: "memory");
        }
        __syncthreads();
        {
            int tv3 = tid; asm volatile("" : "+v"(tv3));
            CS_BASES_OUT(tv3);
            float ov[32]; float ss = 0.f, ss1 = 0.f;
#pragma unroll
            for (int c = 0; c < 4; ++c) { const v4u w = *(const LAS v4u*)(lds + rO + 128 * c);
                ov[8 * c + 0] = blo(w.x); ov[8 * c + 1] = bhi(w.x); ov[8 * c + 2] = blo(w.y); ov[8 * c + 3] = bhi(w.y); ov[8 * c + 4] = blo(w.z); ov[8 * c + 5] = bhi(w.z); ov[8 * c + 6] = blo(w.w); ov[8 * c + 7] = bhi(w.w); }
#pragma unroll
            for (int i = 0; i < 16; ++i) { ss += ov[i] * ov[i]; ss1 += ov[16 + i] * ov[16 + i]; }
            float inv = 1.0f;
            if (HG) { ss += __shfl_xor(ss, 1); ss1 += __shfl_xor(ss1, 1); ss += __shfl_xor(ss, 2); ss1 += __shfl_xor(ss1, 2); ss += __shfl_xor(ss, 4); ss1 += __shfl_xor(ss1, 4);
                if (ocg_ < 2) SSn[orow_ * 8 + 2 * hq + ocg_] = ocg_ ? ss1 : ss; }
            else { ss += ss1; ss += __shfl_xor(ss, 1); ss += __shfl_xor(ss, 2); ss += __shfl_xor(ss, 4); inv = __builtin_amdgcn_rsqf(ss * (1.0f / 256.0f) + NORM_EPS); }
#pragma unroll
            for (int c = 0; c < 4; ++c) {
                const float gt[8] = {blo(pg[c].x), bhi(pg[c].x), blo(pg[c].y), bhi(pg[c].y), blo(pg[c].z), bhi(pg[c].z), blo(pg[c].w), bhi(pg[c].w)};
                float y[8];
                if (HG) {
#pragma unroll
                    for (int e = 0; e < 8; ++e) y[e] = ov[8 * c + e] * gt[e]; }
                else { const f32x4 ga = *(const LAS f32x4*)(lds + GAIN_OFF + 4 * (8 * ocg_ + 64 * c)), gb = *(const LAS f32x4*)(lds + GAIN_OFF + 4 * (8 * ocg_ + 64 * c + 4));
#pragma unroll
                    for (int e = 0; e < 4; ++e) { y[e] = ov[8 * c + e] * inv * ga[e] * gt[e]; y[4 + e] = ov[8 * c + 4 + e] * inv * gb[e] * gt[4 + e]; } }
                *(v4u*)(Yn + vrowV + 128 * c) = (v4u){pkb(y[0], y[1]), pkb(y[2], y[3]), pkb(y[4], y[5]), pkb(y[6], y[7])};
                asm volatile("" ::: "memory");
            }
        }
        Gn += 64 * 2048; Yn += 64 * 2048; SSn += 64 * 8;
    }
    __syncthreads();
#undef CS_LOAD_QK
#undef CS_BASES_PREP
#undef CS_BASES_MMA
#undef CS_BASES_OUT
#undef CS_LOAD_V
#undef CS_LOAD_G
}

template <bool HG>
__device__ __forceinline__ void scan_state_unit(const Ptrs& P, LAS unsigned char* lds, const int tid, const int u, const int seg) {
    constexpr int SETS = HG ? 2 : 1, TPS = 512 / SETS, TG = TPS / 32, NT = 64 / TG;
    constexpr int PQ = HG ? 1024 : 512;
    const int lane = tid & 63, wave = __builtin_amdgcn_readfirstlane(tid >> 6);
    const int b = u >> 2, hq = u & 3;
    const int set = HG ? (wave >> 2) : 0, wset = HG ? (wave & 3) : wave;
    const int vcol0 = hq * 256, vhalf = wave >> 2, vc = wave & 3;
    const size_t rowl = (size_t)b * SEQ + (size_t)seg * (SEG_CH * 64) + (SEG_CH - 1) * 64;
    const char* Kn = (const char*)((HG ? P.hF : P.gK) + rowl * PQ); const char* Zn = (const char*)(P.gZ + rowl * PQ); const char* Vn = (const char*)((HG ? P.hV : P.gV) + rowl * 1024);
    const unsigned K2s = K2_OFF + set * 16384;
#define CS_BASES_PREP(tv) const int ts_ = (tv) & (TPS - 1), dq_ = ts_ & 31, tg_ = ts_ >> 5, orow_ = (tv) >> 3, ocg_ = (tv) & 7; \
    const int dqs_ = (dq_ & ~3) | (((dq_ & 3) == 1) ? 2 : ((dq_ & 3) == 2) ? 1 : (dq_ & 3)); \
    const unsigned vqk = (unsigned)((tg_ * NT) * PQ + (HG ? (2 * hq + set) : hq) * 128 + 4 * dq_) * 2u, vrow = (unsigned)(orow_ * 1024 + vcol0 + 32 * ocg_) * 2u, vrowV = (unsigned)(orow_ * 1024 + vcol0 + 8 * ocg_) * 2u; \
    const unsigned wK2 = K2s + off_b(tg_ * NT, dqs_ >> 1) + 8 * (dqs_ & 1), wK2b = K2s + off_b(tg_ * NT + 4, dqs_ >> 1) + 8 * (dqs_ & 1); \
    const unsigned TOTw = TOT_OFF + (set * (TG * 64) + wset * 128 + 4 * dq_) * 4, TOTr = TOT_OFF + (set * (TG * 64) + 4 * dq_) * 4; \
    const unsigned xV = (orow_ >> 2) & 3, wV = V_OFF + 2048 * (orow_ >> 3) + 64 * (orow_ & 7) + 512 * (ocg_ >> 2) + 16 * ((ocg_ & 3) ^ xV);     (void)wK2b
    f32x16 S[4];
#pragma unroll
    for (int dt = 0; dt < 4; ++dt)
#pragma unroll
        for (int i = 0; i < 16; ++i) S[dt][i] = 0.f;
    f32x4 R = {0.f, 0.f, 0.f, 0.f};
    v2u pkA[NT], pzA[NT], pkB[NT], pzB[NT]; v4u pvA[4], pvB[4];
#define CS_LOAD_K(pk, pz) do { _Pragma("unroll") for (int i_ = 0; i_ < NT; ++i_) { pk[i_] = *(const v2u*)(Kn + i_ * PQ * 2 + vqk); if (!HG) pz[i_] = *(const v2u*)(Zn + i_ * PQ * 2 + vqk); } } while (0)
#define CS_LOAD_V(pv) do { _Pragma("unroll") for (int c_ = 0; c_ < 4; ++c_) pv[c_] = *(const v4u*)(Vn + vrowV + 128 * c_); } while (0)
#define CS_STEP_BACK() do { Kn -= 64 * PQ * 2; Zn -= 64 * PQ * 2; Vn -= 64 * 2048; } while (0)
    { int tv0 = tid; asm volatile("" : "+v"(tv0)); CS_BASES_PREP(tv0); (void)wK2; (void)TOTw; (void)TOTr; (void)wV; (void)xV;
      CS_LOAD_K(pkA, pzA); CS_LOAD_V(pvA); CS_STEP_BACK(); CS_LOAD_K(pkB, pzB); CS_LOAD_V(pvB); CS_STEP_BACK(); }
#define CS_STATE_CHUNK(pk, pz, pv, more) do { \
        int tv1 = tid; asm volatile("" : "+v"(tv1)); \
        CS_BASES_PREP(tv1); \
        float p[NT][4]; \
        _Pragma("unroll") for (int i = 0; i < NT; ++i) { \
            float lg[4]; \
            if (HG) { lg[0] = blo(pk[i].x); lg[1] = bhi(pk[i].x); lg[2] = blo(pk[i].y); lg[3] = bhi(pk[i].y); \
                pk[i].x = pkb(1.0f - __builtin_amdgcn_exp2f(lg[0]), 1.0f - __builtin_amdgcn_exp2f(lg[1])); pk[i].y = pkb(1.0f - __builtin_amdgcn_exp2f(lg[2]), 1.0f - __builtin_amdgcn_exp2f(lg[3])); } \
            else { lg[0] = blo(pz[i].x); lg[1] = bhi(pz[i].x); lg[2] = blo(pz[i].y); lg[3] = bhi(pz[i].y); } \
            _Pragma("unroll") for (int e = 0; e < 4; ++e) p[i][e] = (i ? p[i - 1][e] : 0.f) + lg[e]; \
        } \
        f32x4 glo, gwt; wave_pair((f32x4){p[NT - 1][0], p[NT - 1][1], p[NT - 1][2], p[NT - 1][3]}, glo, gwt); \
        *(LAS f32x4*)(lds + TOTw) = gwt; \
        __syncthreads();        \
        { \
            f32x4 before = ((tv1 & 63) >= 32) ? glo : (f32x4){0.f, 0.f, 0.f, 0.f}, blast = {0.f, 0.f, 0.f, 0.f}; \
            _Pragma("unroll") for (int gg = 0; gg < TG / 2; ++gg) { const f32x4 t = *(const LAS f32x4*)(lds + TOTr + gg * 512); blast += t; if (gg < wset) before += t; } \
            _Pragma("unroll") for (int i = 0; i < NT; ++i) { \
                const float kv[4] = {blo(pk[i].x), bhi(pk[i].x), blo(pk[i].y), bhi(pk[i].y)}; float k3[4]; \
                _Pragma("unroll") for (int e = 0; e < 4; ++e) k3[e] = kv[e] * __builtin_amdgcn_exp2f(blast[e] - before[e] - p[i][e] + R[e]); \
                *(LAS v2u*)(lds + (i < 4 ? wK2 + 64 * i : wK2b + 64 * (i - 4))) = (v2u){pkb(k3[0], k3[1]), pkb(k3[2], k3[3])}; } \
            R += blast; \
            _Pragma("unroll") for (int c = 0; c < 4; ++c) *(LAS v4u*)(lds + wV + 16384 * (c >> 1) + 1024 * (c & 1)) = pv[c]; \
        } \
        __syncthreads(); \
        if (more) { CS_LOAD_K(pk, pz); CS_LOAD_V(pv); CS_STEP_BACK(); } \
        int tv2 = tid; asm volatile("" : "+v"(tv2)); \
        const int lm_ = tv2 & 63; \
        const unsigned rV[2] = {V_OFF + vhalf * 16384 + tr_addr(lm_, vc, 0, 0), V_OFF + vhalf * 16384 + tr_addr(lm_, vc, 0, 1)}; \
        const unsigned rK[2] = {K2s + tr_addr(lm_, 0, 0, 0), K2s + tr_addr(lm_, 0, 0, 1)}; \
        bf16x8 vf[4]; \
        _Pragma("unroll") for (int ks = 0; ks < 4; ++ks) vf[ks] = cat8(tr_read(lds + rV[0] + 4096 * ks), tr_read(lds + rV[1] + 4096 * ks)); \
        _Pragma("unroll") for (int dt = 0; dt < 4; ++dt) { \
            _Pragma("unroll") for (int ks = 0; ks < 4; ++ks) S[dt] = CS_MFMA32(cat8(tr_read(lds + rK[0] + 512 * dt + 4096 * ks), tr_read(lds + rK[1] + 512 * dt + 4096 * ks)), vf[ks], S[dt]); \
            asm volatile("" ::: "memory"); \
        } \
    } while (0)
    static_assert(SEG_CH % 2 == 0, "the state pass takes two chunks per trip");
    for (int n = 0; n < SEG_CH; n += 2) {
        const bool more = (n + 2 < SEG_CH);
        CS_STATE_CHUNK(pkA, pzA, pvA, more);
        CS_STATE_CHUNK(pkB, pzB, pvB, more);
    }
#undef CS_STATE_CHUNK
#undef CS_STEP_BACK
    {
        float* Lp = P.segL + ((size_t)(u * (NSEG - 1) + seg) * 8 + wave) * 4096 + lane;
#pragma unroll
        for (int dt = 0; dt < 4; ++dt)
#pragma unroll
            for (int i = 0; i < 16; ++i) Lp[(dt * 16 + i) * 64] = S[dt][i];
        const int ts = tid & (TPS - 1), dq = ts & 31, tg = ts >> 5, dqs = (dq & ~3) | (((dq & 3) == 1) ? 2 : ((dq & 3) == 2) ? 1 : (dq & 3));
        if (tg == 0) *(f32x4*)(P.segB + (size_t)((u * (NSEG - 1) + seg) * 2 + set) * 128 + 4 * dqs) = R;
    }
    __syncthreads();
#undef CS_BASES_PREP
#undef CS_LOAD_K
#undef CS_LOAD_V
}
}
struct Args { const float* in[15]; float* out; unsigned char* ws; int ph_lo, ph_hi, li, pad; };
__global__ void __launch_bounds__(NWAVES * 64, 2) fwd(Args args) {
    extern __shared__ __attribute__((aligned(16))) unsigned char lds_raw[];
    LAS unsigned char* lds = (LAS unsigned char*)lds_raw;
    volatile LAS unsigned* MISC = (volatile LAS unsigned*)(lds + MISC_OFF);
    const int tid = threadIdx.x, lane = tid & 63, wave = __builtin_amdgcn_readfirstlane(tid >> 6), G = gridDim.x;
    unsigned char* ws = args.ws;
    Ptrs P;
    P.x = args.in[0]; P.mixer_norm = args.in[1]; P.ffn_norm = args.in[2]; P.gla_w_in = args.in[3]; P.gla_w_gu = args.in[4]; P.gla_b_gate = args.in[5]; P.gla_head_norm = args.in[6]; P.gla_w_out = args.in[7];
    P.hg_w_in = args.in[8]; P.hg_lb = args.in[9]; P.hg_out_norm = args.in[10]; P.hg_w_out = args.in[11]; P.ffn_w_in = args.in[12]; P.ffn_w_out = args.in[13]; P.final_norm = args.in[14]; P.out = args.out;
    P.Wgla = (bf16*)(ws + WS_W_GLA); P.Wo0 = (bf16*)(ws + WS_W_O0); P.Wf0i = (bf16*)(ws + WS_W_F0I); P.Wf0o = (bf16*)(ws + WS_W_F0O); P.Whg = (bf16*)(ws + WS_W_HG); P.Wo1 = (bf16*)(ws + WS_W_O1); P.Wf1i = (bf16*)(ws + WS_W_F1I); P.Wf1o = (bf16*)(ws + WS_W_F1O);
    P.rowss = (float*)(ws + WS_ROWSS); P.ssqh = (float*)(ws + WS_SSQH); P.segL = (float*)(ws + WS_SEGL); P.segB = (float*)(ws + WS_SEGB); P.lbt = (float*)(ws + WS_LBT); P.XB = (bf16*)(ws + WS_XB); P.YB = (bf16*)(ws + WS_YB); P.HB = (bf16*)(ws + WS_HB);
    P.gQ = (bf16*)(ws + WS_P0); P.gK = (bf16*)(ws + WS_P0 + 64 * MiB); P.gV = (bf16*)(ws + WS_P0 + 128 * MiB); P.gR = (bf16*)(ws + WS_P0 + 256 * MiB); P.gZ = (bf16*)(ws + WS_P0 + 384 * MiB);
    P.hQ = (bf16*)(ws + WS_P0); P.hF = (bf16*)(ws + WS_P0 + 128 * MiB); P.hV = (bf16*)(ws + WS_P0 + 256 * MiB); P.hG = (bf16*)(ws + WS_P0 + 384 * MiB);
    for (int u = tid; u < (LDS_BYTES - LDSCTL_OFF) / 4; u += NWAVES * 64) ((LAS unsigned*)(lds + LDSCTL_OFF))[u] = 0u;
    __syncthreads();
    XcdBarrier bar; bar.bar = (unsigned*)(ws + WS_CTL); bar.x = 0; bar.st = nullptr;
    if (!MK_PER_PHASE) bar = xcd_barrier_post((unsigned*)(ws + WS_CTL), MISC + 8);
#define GRID_BAR() do { if (!MK_PER_PHASE) xcd_barrier(bar); } while (0)
    const int lo = args.ph_lo, hi = args.ph_hi;
#define IN(k) (lo <= (k) && (k) < hi)
#define BOTH(k) (IN(k) && IN((k) + 1))

    if (IN(0)) { p0_prologue(P, lds, wave, lane, G); if (BOTH(0)) GRID_BAR(); }
    typedef pg8::EpiResid<0, true> RESID_F32IN; typedef pg8::EpiResid<0, false> RESID_BF; typedef pg8::EpiResid<0, false, true> RESID_BF_HT;     typedef pg8::EpiResid<8, false> RESID_BF8;
#define GEMM_PHASE(k, EPI, AOP, BOP, NN, KK, ...) if (IN(k)) { \
        pg8::Gemm g{AOP, BOP, M, NN, KK}; pg8::StaticOrder S; S.init(M, NN, G, (int)blockIdx.x); EPI E{__VA_ARGS__}; \
        pg8::gemm_phase<EPI, pg8::StaticOrder, PG8_ALIGN, PG8_SP2>(lds + RING_OFF, g, S, E); if (BOTH(k)) GRID_BAR(); }
#define SCAN_PHASE(k, FN, HGF, NUNITS) if (IN(k)) { \
        for (int w = blockIdx.x; w < (NUNITS); w += G) cs::FN<HGF>(P, lds, tid, w & 63, w >> 6); if (BOTH(k)) GRID_BAR(); }
    GEMM_PHASE(1, pg8::EpiProjGLA, P.XB, P.Wgla, GLA_N, D, P.gQ, P.gK, P.gV, P.gR, P.gZ, P.rowss, P.gla_b_gate)
    SCAN_PHASE(2, scan_state_unit, false, 64 * (cs::NSEG - 1))
    SCAN_PHASE(3, scan_chunk_unit, false, 64 * cs::NSEG)
    GEMM_PHASE(4, RESID_F32IN, P.YB, P.Wo0, D, D, P.x, P.XB, P.rowss, nullptr)
    GEMM_PHASE(5, pg8::EpiSwiGLU, P.XB, P.Wf0i, FF2, D, P.HB, FF, P.rowss)
    GEMM_PHASE(6, RESID_BF_HT, P.HB, P.Wf0o, D, FF, nullptr, P.XB, P.rowss, nullptr)
    GEMM_PHASE(7, pg8::EpiProjHG, P.XB, P.Whg, HG_N, D, P.hQ, P.hF, P.hV, P.hG, P.rowss, P.lbt)
    SCAN_PHASE(8, scan_state_unit, true, 64 * (cs::NSEG - 1))
    SCAN_PHASE(9, scan_chunk_unit, true, 64 * cs::NSEG)
    GEMM_PHASE(10, RESID_BF8, P.YB, P.Wo1, D, D, nullptr, P.XB, P.rowss, P.ssqh)
    GEMM_PHASE(11, pg8::EpiSwiGLU, P.XB, P.Wf1i, FF2, D, P.HB, FF, P.rowss)
    GEMM_PHASE(12, RESID_BF_HT, P.HB, P.Wf1o, D, FF, nullptr, P.XB, P.rowss, nullptr)
    if (IN(13)) final_norm_rows(P, wave, lane, G);
#undef GEMM_PHASE
#undef SCAN_PHASE
#undef IN
#undef BOTH
}

extern "C" void kernel_launch(void* const* d_in, const int* in_sizes, int n_in, void* d_out, int out_size, void* d_ws, size_t ws_size, hipStream_t stream) {
    static int grid = 0;
    if (grid == 0) {
        if (n_in != 15 || in_sizes[0] != M * D || out_size != M * D || ws_size < WS_END) { fprintf(stderr, "kernel_launch: unexpected shapes (n_in %d, in0 %d, out %d, ws %zu)\n", n_in, n_in > 0 ? in_sizes[0] : -1, out_size, ws_size); grid = -1; return; }
        int dev = 0, cus = 0, per_cu = 0;
        if (hipGetDevice(&dev) != hipSuccess || hipDeviceGetAttribute(&cus, hipDeviceAttributeMultiprocessorCount, dev) != hipSuccess) { grid = -1; return; }
        if (hipFuncSetAttribute((const void*)fwd, hipFuncAttributeMaxDynamicSharedMemorySize, LDS_BYTES) != hipSuccess) { fprintf(stderr, "kernel_launch: hipFuncSetAttribute failed\n"); grid = -1; return; }
        if (hipOccupancyMaxActiveBlocksPerMultiprocessor(&per_cu, (const void*)fwd, NWAVES * 64, LDS_BYTES) != hipSuccess || per_cu < 1) fprintf(stderr, "kernel_launch: occupancy query reports %d\n", per_cu);
        (void)hipGetLastError();
        grid = 256; while (grid > cus) grid >>= 1;
    }
    if (grid < 0) return;
    if (hipMemsetAsync((char*)d_ws + WS_CTL, 0, CTL_ZERO_BYTES, stream) != hipSuccess) return;
    Args a{};
    for (int i = 0; i < 15; ++i) a.in[i] = (const float*)d_in[i];
    a.out = (float*)d_out; a.ws = (unsigned char*)d_ws;
#if MK_PER_PHASE
    for (int k = 0; k < N_PHASES; ++k) { a.ph_lo = k; a.ph_hi = k + 1; a.li = k;
        hipLaunchKernelGGL(fwd, dim3(grid), dim3(NWAVES * 64), LDS_BYTES, stream, a);
    }
#else
    a.ph_lo = 0; a.ph_hi = N_PHASES; a.li = 0;
    hipLaunchKernelGGL(fwd, dim3(grid), dim3(NWAVES * 64), LDS_BYTES, stream, a);
#endif
}
```
